# Optimizing an MI355X kernel written in HIP

```python
import math
import jax, jax.numpy as jnp
from jax import lax
import numpy as np

D_MODEL = 1024
BATCH = 1
SEQ = 16384
DEPTH = 1

D_MIX = D_MODEL
LRU_WIDTH = D_MIX // 2
LRU_BLOCKS = 8
LRU_BLOCK = LRU_WIDTH // LRU_BLOCKS
CONV_LRU = 4
LRU_C = 8.0
N_DIFF_HEADS = 4
DIFF_HEAD_DIM = 64
DIFF_V_DIM = 2 * DIFF_HEAD_DIM
QK_WIDTH = N_DIFF_HEADS * 2 * DIFF_HEAD_DIM
ATTN_WIDTH = N_DIFF_HEADS * DIFF_V_DIM
D_IN = 2 * QK_WIDTH + ATTN_WIDTH + 2 * LRU_WIDTH
D_FF = 3 * D_MODEL
CONV_FFN = 3
NUM_BUCKETS = 32
MAX_EXACT = NUM_BUCKETS // 2
MAX_DISTANCE = 128
Q_BLOCK = 128
EPS = 1e-6
NEG_INF = -1e30

kernel_name = 'hybrid_rglru_diffattn_convffn_block'


def rms_norm(x, g):
    xf = x.astype(jnp.float32)
    y = xf * lax.rsqrt(jnp.mean(xf * xf, axis=-1, keepdims=True) + EPS)
    return (y * g.astype(jnp.float32)).astype(x.dtype)


def causal_dwconv(x, w, b):
    k = w.shape[0]
    s = x.shape[1]
    xp = jnp.pad(x, ((0, 0), (k - 1, 0), (0, 0)))
    y = b
    for j in range(k):
        y = y + xp[:, j:j + s] * w[j]
    return y


def block_diag_linear(x, w, b):
    xb = x.reshape(x.shape[:-1] + (LRU_BLOCKS, LRU_BLOCK))
    y = jnp.einsum('bsnc,ncd->bsnd', xb, w)
    return y.reshape(x.shape) + b


def rg_lru(x, w_a, b_a, w_x, b_x, lam):
    xf = x.astype(jnp.float32)
    r = jax.nn.sigmoid(block_diag_linear(xf, w_a.astype(jnp.float32), b_a.astype(jnp.float32)))
    i = jax.nn.sigmoid(block_diag_linear(xf, w_x.astype(jnp.float32), b_x.astype(jnp.float32)))
    log_a = -LRU_C * r * jax.nn.softplus(-lam.astype(jnp.float32))
    a = jnp.exp(log_a)
    b_in = jnp.sqrt(-jnp.expm1(2.0 * log_a)) * (i * xf)

    def combine(left, right):
        a1, b1 = left
        a2, b2 = right
        return a1 * a2, a2 * b1 + b2

    _, h = lax.associative_scan(combine, (a, b_in), axis=1)
    return h.astype(x.dtype)


def t5_bucket(rel):
    n = jnp.maximum(rel, 0)
    nf = jnp.maximum(n, 1).astype(jnp.float32)
    large = MAX_EXACT + (jnp.log(nf / MAX_EXACT) / math.log(MAX_DISTANCE / MAX_EXACT)
                         * (NUM_BUCKETS - MAX_EXACT)).astype(jnp.int32)
    large = jnp.minimum(large, NUM_BUCKETS - 1)
    return jnp.where(n < MAX_EXACT, n, large)


def diff_attention(q, k, v, rel_table, lam):
    b, s = q.shape[0], q.shape[1]
    nb = s // Q_BLOCK
    qb = q.reshape(b, nb, Q_BLOCK, N_DIFF_HEADS, 2, DIFF_HEAD_DIM).transpose(1, 0, 2, 3, 4, 5)
    kpos = jnp.arange(s, dtype=jnp.int32)
    scale = DIFF_HEAD_DIM ** -0.5

    def block(args):
        idx, qblk = args
        qpos = idx * Q_BLOCK + jnp.arange(Q_BLOCK, dtype=jnp.int32)
        rel = qpos[:, None] - kpos[None, :]
        bias = jnp.take(rel_table, t5_bucket(rel), axis=0)
        bias = jnp.transpose(bias, (2, 0, 1)).astype(jnp.float32)
        sc = jnp.einsum('bqhmd,bkhmd->bhmqk', qblk, k,
                        preferred_element_type=jnp.float32) * scale + bias[None, :, None]
        sc = jnp.where(rel >= 0, sc, NEG_INF)
        p = jax.nn.softmax(sc, axis=-1)
        wts = p[:, :, 0] - lam * p[:, :, 1]
        return jnp.einsum('bhqk,bkhd->bqhd', wts.astype(v.dtype), v)

    out = lax.map(block, (jnp.arange(nb, dtype=jnp.int32), qb))
    return out.transpose(1, 0, 2, 3, 4).reshape(b, s, N_DIFF_HEADS, DIFF_V_DIM)


def setup_inputs(seed: int = 0) -> dict:
    key = jax.random.key(seed)
    ks = jax.random.split(key, 32)
    f32 = jnp.float32
    nrm = lambda k, shape, s: jax.random.normal(k, shape, f32) * s
    gain = lambda k, shape: 1.0 + 0.02 * jax.random.normal(k, shape, f32)
    u = jax.random.uniform(ks[12], (DEPTH, LRU_WIDTH), f32, 0.9, 0.999)
    a_base = u ** (1.0 / LRU_C)
    lru_lambda = jnp.log(a_base) - jnp.log1p(-a_base)
    return {
        'x': nrm(ks[0], (BATCH, SEQ, D_MODEL), 1.0),
        'c': nrm(ks[1], (BATCH, D_MODEL), 1.0),
        'w_ada': nrm(ks[2], (DEPTH, D_MODEL, 6 * D_MODEL), 0.5 * D_MODEL ** -0.5),
        'b_ada': nrm(ks[3], (DEPTH, 6 * D_MODEL), 0.02),
        'g_norm1': gain(ks[4], (DEPTH, D_MODEL)),
        'w_in': nrm(ks[5], (DEPTH, D_MODEL, D_IN), D_MODEL ** -0.5),
        'conv_lru_w': nrm(ks[6], (DEPTH, CONV_LRU, LRU_WIDTH), 0.5),
        'conv_lru_b': nrm(ks[7], (DEPTH, LRU_WIDTH), 0.02),
        'lru_wa': nrm(ks[8], (DEPTH, LRU_BLOCKS, LRU_BLOCK, LRU_BLOCK), LRU_BLOCK ** -0.5),
        'lru_ba': nrm(ks[9], (DEPTH, LRU_WIDTH), 0.02),
        'lru_wx': nrm(ks[10], (DEPTH, LRU_BLOCKS, LRU_BLOCK, LRU_BLOCK), LRU_BLOCK ** -0.5),
        'lru_bx': nrm(ks[11], (DEPTH, LRU_WIDTH), 0.02),
        'lru_lambda': lru_lambda,
        'lam_q1': nrm(ks[13], (DEPTH, DIFF_HEAD_DIM), 0.1),
        'lam_k1': nrm(ks[14], (DEPTH, DIFF_HEAD_DIM), 0.1),
        'lam_q2': nrm(ks[15], (DEPTH, DIFF_HEAD_DIM), 0.1),
        'lam_k2': nrm(ks[16], (DEPTH, DIFF_HEAD_DIM), 0.1),
        'g_subln': gain(ks[17], (DEPTH, DIFF_V_DIM)),
        'w_out': nrm(ks[18], (DEPTH, D_MIX, D_MODEL), D_MIX ** -0.5),
        'g_norm2': gain(ks[19], (DEPTH, D_MODEL)),
        'w_up': nrm(ks[20], (DEPTH, D_MODEL, 2 * D_FF), D_MODEL ** -0.5),
        'conv_ffn_w': nrm(ks[21], (DEPTH, CONV_FFN, D_FF), 0.5),
        'conv_ffn_b': nrm(ks[22], (DEPTH, D_FF), 0.02),
        'w_down': nrm(ks[23], (DEPTH, D_FF, D_MODEL), D_FF ** -0.5),
        'rel_bias': nrm(ks[24], (NUM_BUCKETS, N_DIFF_HEADS), 0.5),
        'g_final': gain(ks[25], (D_MODEL,)),
    }


def reference(x, c, w_ada, b_ada, g_norm1, w_in, conv_lru_w, conv_lru_b, lru_wa, lru_ba,
              lru_wx, lru_bx, lru_lambda, lam_q1, lam_k1, lam_q2, lam_k2, g_subln, w_out,
              g_norm2, w_up, conv_ffn_w, conv_ffn_b, w_down, rel_bias, g_final):
    b, s, _ = x.shape
    splits = [QK_WIDTH, 2 * QK_WIDTH, 2 * QK_WIDTH + ATTN_WIDTH, 2 * QK_WIDTH + ATTN_WIDTH + LRU_WIDTH]
    cond = jax.nn.silu(c)
    for l in range(DEPTH):
        mod = cond @ w_ada[l] + b_ada[l]
        shift1, scale1, gate1, shift2, scale2, gate2 = jnp.split(mod[:, None, :], 6, axis=-1)

        h = rms_norm(x, g_norm1[l]) * (1.0 + scale1) + shift1
        proj = h @ w_in[l]
        q, k, v, xr, yg = jnp.split(proj, splits, axis=-1)
        q = q.reshape(b, s, N_DIFF_HEADS, 2, DIFF_HEAD_DIM)
        k = k.reshape(b, s, N_DIFF_HEADS, 2, DIFF_HEAD_DIM)
        v = v.reshape(b, s, N_DIFF_HEADS, DIFF_V_DIM)

        lambda_init = 0.8 - 0.6 * math.exp(-0.3 * l)
        lam = (jnp.exp(jnp.sum(lam_q1[l].astype(jnp.float32) * lam_k1[l].astype(jnp.float32)))
               - jnp.exp(jnp.sum(lam_q2[l].astype(jnp.float32) * lam_k2[l].astype(jnp.float32)))
               + lambda_init)
        attn = diff_attention(q, k, v, rel_bias, lam)
        attn = (rms_norm(attn, g_subln[l]) * (1.0 - lambda_init)).reshape(b, s, ATTN_WIDTH)

        xr = causal_dwconv(xr, conv_lru_w[l], conv_lru_b[l])
        lru = rg_lru(xr, lru_wa[l], lru_ba[l], lru_wx[l], lru_bx[l], lru_lambda[l])
        lru = lru * jax.nn.gelu(yg, approximate=True)

        mix = jnp.concatenate([lru, attn], axis=-1) @ w_out[l]
        x = x + gate1 * mix

        h = rms_norm(x, g_norm2[l]) * (1.0 + scale2) + shift2
        a, g = jnp.split(h @ w_up[l], 2, axis=-1)
        a = causal_dwconv(a, conv_ffn_w[l], conv_ffn_b[l])
        ff = (jax.nn.gelu(a, approximate=True) * g) @ w_down[l]
        x = x + gate2 * ff
    return rms_norm(x, g_final)
```

```cpp
#include <hip/hip_runtime.h>
#include <cstdint>
#include <cstdio>

namespace {
constexpr int S = 16384, D = 1024, DIN = 2560, DFF = 3072;
constexpr int NH = 4, DH = 64, DV = 128;
constexpr float EPS = 1e-6f;

__device__ __forceinline__ float sigmoidf_(float x) { return 1.f / (1.f + expf(-x)); }
__device__ __forceinline__ float gelu_tanh(float x) { const float u = 0.7978845608028654f * (x + 0.044715f * x * x * x); return 0.5f * x * (1.f + tanhf(u)); }
__device__ __forceinline__ int t5_bucket(int n) {
    if (n < 16) return n;
    const int v = 16 + (int)(logf((float)n / 16.f) / logf(8.f) * 16.f);
    return v < 31 ? v : 31;
}

__global__ void k_mod(const float* __restrict__ c, const float* __restrict__ w, const float* __restrict__ b, float* __restrict__ mod) {
    __shared__ float sc[D];
    for (int k = threadIdx.x; k < D; k += blockDim.x) { const float v = c[k]; sc[k] = v / (1.f + expf(-v)); }
    __syncthreads();
    const int j = blockIdx.x * blockDim.x + threadIdx.x;
    float acc = 0.f;
    for (int k = 0; k < D; ++k) acc += sc[k] * w[(size_t)k * 6144 + j];
    mod[j] = acc + b[j];
}

__global__ void k_norm(const float* __restrict__ x, const float* __restrict__ g, const float* __restrict__ scale, const float* __restrict__ shift, float* __restrict__ out) {
    const int row = blockIdx.x, tid = threadIdx.x;
    const float4 v = ((const float4*)(x + (size_t)row * D))[tid];
    float s = v.x * v.x + v.y * v.y + v.z * v.z + v.w * v.w;
    for (int o = 32; o > 0; o >>= 1) s += __shfl_xor(s, o);
    __shared__ float red[4];
    if ((tid & 63) == 0) red[tid >> 6] = s;
    __syncthreads();
    s = red[0] + red[1] + red[2] + red[3];
    const float r = rsqrtf(s * (1.f / D) + EPS);
    const float4 gg = ((const float4*)g)[tid];
    float4 o4 = {v.x * r * gg.x, v.y * r * gg.y, v.z * r * gg.z, v.w * r * gg.w};
    if (scale) {
        const float4 sc = ((const float4*)scale)[tid], sh = ((const float4*)shift)[tid];
        o4.x = o4.x * (1.f + sc.x) + sh.x; o4.y = o4.y * (1.f + sc.y) + sh.y; o4.z = o4.z * (1.f + sc.z) + sh.z; o4.w = o4.w * (1.f + sc.w) + sh.w;
    }
    ((float4*)(out + (size_t)row * D))[tid] = o4;
}

template <int MODE>
__global__ void __launch_bounds__(256) k_gemm(const float* __restrict__ A, int lda, int arow0, const float* __restrict__ B, int ldb, float* C, int ldc,
                                              int K, const float* resid, const float* __restrict__ gate) {
    __shared__ float As[16][65];
    __shared__ float Bs[16][64];
    const int tid = threadIdx.x, tx = tid & 15, ty = tid >> 4;
    const int m0 = blockIdx.y * 64, n0 = blockIdx.x * 64;
    float acc[4][4];
#pragma unroll
    for (int i = 0; i < 4; ++i)
#pragma unroll
        for (int j = 0; j < 4; ++j) acc[i][j] = 0.f;
    for (int k0 = 0; k0 < K; k0 += 16) {
        {
            const int r = tid >> 2, kk = (tid & 3) * 4; const int grow = arow0 + m0 + r;
            float4 v = {0.f, 0.f, 0.f, 0.f};
            if (grow >= 0 && grow < S) v = *(const float4*)(A + (size_t)grow * lda + k0 + kk);
            As[kk + 0][r] = v.x; As[kk + 1][r] = v.y; As[kk + 2][r] = v.z; As[kk + 3][r] = v.w;
        }
        {
            const int kk = tid >> 4, nn = (tid & 15) * 4;
            const float4 v = *(const float4*)(B + (size_t)(k0 + kk) * ldb + n0 + nn);
            *(float4*)&Bs[kk][nn] = v;
        }
        __syncthreads();
#pragma unroll
        for (int kk = 0; kk < 16; ++kk) {
            float a[4], b[4];
#pragma unroll
            for (int i = 0; i < 4; ++i) a[i] = As[kk][ty * 4 + i];
#pragma unroll
            for (int j = 0; j < 4; ++j) b[j] = Bs[kk][tx * 4 + j];
#pragma unroll
            for (int i = 0; i < 4; ++i)
#pragma unroll
                for (int j = 0; j < 4; ++j) acc[i][j] += a[i] * b[j];
        }
        __syncthreads();
    }
#pragma unroll
    for (int i = 0; i < 4; ++i) {
        const int m = m0 + ty * 4 + i;
#pragma unroll
        for (int j = 0; j < 4; ++j) {
            const int n = n0 + tx * 4 + j;
            float v = acc[i][j];
            if (MODE == 1) v = resid[(size_t)m * ldc + n] + gate[n] * v;
            C[(size_t)m * ldc + n] = v;
        }
    }
}

__global__ void __launch_bounds__(64) k_attn(const float* __restrict__ proj, const float* __restrict__ rel_bias, float* __restrict__ O) {
    __shared__ float Ks[32][64];
    __shared__ float Vs[32][128];
    __shared__ float btab[160];
    const int lane = threadIdx.x, hm = blockIdx.y, h = hm >> 1, mm = hm & 1;
    const int t = blockIdx.x * 64 + lane;
    for (int n = lane; n < 160; n += 64) btab[n] = rel_bias[t5_bucket(n) * NH + h];
    const float b_far = rel_bias[31 * NH + h];
    float q[64], o[128];
#pragma unroll
    for (int d = 0; d < 64; ++d) q[d] = proj[(size_t)t * DIN + h * 128 + mm * 64 + d] * 0.125f;
#pragma unroll
    for (int d = 0; d < 128; ++d) o[d] = 0.f;
    float mx = -1e30f, l = 0.f;
    const int jend = blockIdx.x * 64 + 64;
    for (int j0 = 0; j0 < jend; j0 += 32) {
        __syncthreads();
        for (int i = lane; i < 32 * 16; i += 64) { const int r = i >> 4, c4 = (i & 15) * 4; *(float4*)&Ks[r][c4] = *(const float4*)(proj + (size_t)(j0 + r) * DIN + 512 + h * 128 + mm * 64 + c4); }
        for (int i = lane; i < 32 * 32; i += 64) { const int r = i >> 5, c4 = (i & 31) * 4; *(float4*)&Vs[r][c4] = *(const float4*)(proj + (size_t)(j0 + r) * DIN + 1024 + h * 128 + c4); }
        __syncthreads();
        for (int jj = 0; jj < 32; ++jj) {
            const int kp = j0 + jj; const int rel = t - kp;
            float s = 0.f;
#pragma unroll
            for (int d = 0; d < 64; d += 4) { const float4 kv = *(const float4*)&Ks[jj][d]; s += q[d] * kv.x + q[d + 1] * kv.y + q[d + 2] * kv.z + q[d + 3] * kv.w; }
            s += (rel >= 0 && rel < 160) ? btab[rel < 0 ? 0 : (rel < 160 ? rel : 0)] : b_far;
            if (rel < 0) s = -1e30f;
            const float mn = fmaxf(mx, s);
            const float sc = expf(mx - mn), p = (rel < 0) ? 0.f : expf(s - mn);
            l = l * sc + p; mx = mn;
#pragma unroll
            for (int d = 0; d < 128; d += 4) { const float4 vv = *(const float4*)&Vs[jj][d]; o[d] = o[d] * sc + p * vv.x; o[d + 1] = o[d + 1] * sc + p * vv.y; o[d + 2] = o[d + 2] * sc + p * vv.z; o[d + 3] = o[d + 3] * sc + p * vv.w; }
        }
    }
    const float il = 1.f / l;
#pragma unroll
    for (int d = 0; d < 128; d += 4) { float4 w = {o[d] * il, o[d + 1] * il, o[d + 2] * il, o[d + 3] * il}; *(float4*)(O + (size_t)t * 1024 + hm * 128 + d) = w; }
}

__global__ void k_attn_combine(const float* __restrict__ O, const float* lq1, const float* lk1, const float* lq2, const float* lk2, const float* __restrict__ gsub, float* __restrict__ mixin) {
    const int lane = threadIdx.x & 63, w = threadIdx.x >> 6; const int item = blockIdx.x * 4 + w; const int t = item >> 2, h = item & 3;
    float s1 = lq1[lane] * lk1[lane], s2 = lq2[lane] * lk2[lane];
    for (int o = 32; o > 0; o >>= 1) { s1 += __shfl_xor(s1, o); s2 += __shfl_xor(s2, o); }
    const float lam = expf(s1) - expf(s2) + 0.2f;
    const float* o0 = O + (size_t)t * 1024 + (h * 2) * 128; const float* o1 = o0 + 128;
    const float a = o0[lane] - lam * o1[lane], b = o0[lane + 64] - lam * o1[lane + 64];
    float ss = a * a + b * b;
    for (int o = 32; o > 0; o >>= 1) ss += __shfl_xor(ss, o);
    const float r = rsqrtf(ss * (1.f / 128.f) + EPS) * 0.8f;
    mixin[(size_t)t * 1024 + 512 + h * 128 + lane] = a * r * gsub[lane];
    mixin[(size_t)t * 1024 + 512 + h * 128 + lane + 64] = b * r * gsub[lane + 64];
}

__global__ void __launch_bounds__(64) k_lru_gates(const float* __restrict__ proj, const float* __restrict__ cw, const float* __restrict__ cb, const float* __restrict__ wa, const float* __restrict__ ba,
                                                   const float* __restrict__ wx, const float* __restrict__ bx, const float* __restrict__ lam, float* __restrict__ Ab, float* __restrict__ Bb) {
    __shared__ float xc[16][64];
    const int d = threadIdx.x, n = blockIdx.y, ch = n * 64 + d, t0 = blockIdx.x * 16;
    const float w0 = cw[0 * 512 + ch], w1 = cw[1 * 512 + ch], w2 = cw[2 * 512 + ch], w3 = cw[3 * 512 + ch], bb = cb[ch];
    for (int i = 0; i < 16; ++i) {
        const int t = t0 + i; float y = bb;
        if (t - 3 >= 0) y += w0 * proj[(size_t)(t - 3) * DIN + 1536 + ch];
        if (t - 2 >= 0) y += w1 * proj[(size_t)(t - 2) * DIN + 1536 + ch];
        if (t - 1 >= 0) y += w2 * proj[(size_t)(t - 1) * DIN + 1536 + ch];
        y += w3 * proj[(size_t)t * DIN + 1536 + ch];
        xc[i][d] = y;
    }
    __syncthreads();
    const float sp = log1pf(expf(-lam[ch]));
    for (int i = 0; i < 16; ++i) {
        float ra = ba[ch], ri = bx[ch];
        for (int c = 0; c < 64; ++c) { const float xv = xc[i][c]; ra += xv * wa[(size_t)n * 4096 + c * 64 + d]; ri += xv * wx[(size_t)n * 4096 + c * 64 + d]; }
        const float r = sigmoidf_(ra), ig = sigmoidf_(ri);
        const float log_a = -8.f * r * sp; const float a = expf(log_a);
        const float bin = sqrtf(-expm1f(2.f * log_a)) * (ig * xc[i][d]);
        Ab[(size_t)(t0 + i) * 512 + ch] = a; Bb[(size_t)(t0 + i) * 512 + ch] = bin;
    }
}
__global__ void k_lru_scan(const float* __restrict__ Ab, const float* __restrict__ Bb, const float* __restrict__ proj, float* __restrict__ mixin) {
    const int ch = blockIdx.x * blockDim.x + threadIdx.x;
    float h = 0.f;
    for (int t0 = 0; t0 < S; t0 += 8) {
        float a[8], b[8], y[8];
#pragma unroll
        for (int i = 0; i < 8; ++i) { a[i] = Ab[(size_t)(t0 + i) * 512 + ch]; b[i] = Bb[(size_t)(t0 + i) * 512 + ch]; y[i] = proj[(size_t)(t0 + i) * DIN + 2048 + ch]; }
#pragma unroll
        for (int i = 0; i < 8; ++i) { h = a[i] * h + b[i]; mixin[(size_t)(t0 + i) * 1024 + ch] = h * gelu_tanh(y[i]); }
    }
}
__global__ void k_ffn_act(const float* __restrict__ up, const float* __restrict__ cw, const float* __restrict__ cb, float* __restrict__ hmid, int rows) {
    const size_t idx = (size_t)blockIdx.x * blockDim.x + threadIdx.x;
    if (idx >= (size_t)rows * DFF) return;
    const int m = (int)(idx / DFF), n = (int)(idx % DFF);
    const float a0 = up[(size_t)(m + 0) * 6144 + n], a1 = up[(size_t)(m + 1) * 6144 + n], a2 = up[(size_t)(m + 2) * 6144 + n];
    const float y = cb[n] + cw[0 * DFF + n] * a0 + cw[1 * DFF + n] * a1 + cw[2 * DFF + n] * a2;
    hmid[idx] = gelu_tanh(y) * up[(size_t)(m + 2) * 6144 + DFF + n];
}
}

extern "C" void kernel_launch(void* const* d_in, const int* in_sizes, int n_in, void* d_out, int out_size, void* d_ws, size_t ws_size, hipStream_t stream) {
    const float* x = (const float*)d_in[0]; const float* c = (const float*)d_in[1]; const float* w_ada = (const float*)d_in[2]; const float* b_ada = (const float*)d_in[3];
    const float* g1 = (const float*)d_in[4]; const float* w_in = (const float*)d_in[5]; const float* clw = (const float*)d_in[6]; const float* clb = (const float*)d_in[7];
    const float* wa = (const float*)d_in[8]; const float* ba = (const float*)d_in[9]; const float* wx = (const float*)d_in[10]; const float* bx = (const float*)d_in[11];
    const float* llam = (const float*)d_in[12]; const float* lq1 = (const float*)d_in[13]; const float* lk1 = (const float*)d_in[14]; const float* lq2 = (const float*)d_in[15];
    const float* lk2 = (const float*)d_in[16]; const float* gsub = (const float*)d_in[17]; const float* w_out = (const float*)d_in[18]; const float* g2 = (const float*)d_in[19];
    const float* w_up = (const float*)d_in[20]; const float* cfw = (const float*)d_in[21]; const float* cfb = (const float*)d_in[22]; const float* w_down = (const float*)d_in[23];
    const float* relb = (const float*)d_in[24]; const float* gfin = (const float*)d_in[25];
    float* out = (float*)d_out;
    char* ws = (char*)d_ws;
    const size_t MiB = 1u << 20;
    float* mod = (float*)(ws);
    float* H = (float*)(ws + 1 * MiB);
    float* PROJ = (float*)(ws + 65 * MiB);
    float* AB = (float*)(ws + 225 * MiB);
    (void)AB;
    const float *shift1 = mod, *scale1 = mod + 1024, *gate1 = mod + 2048, *shift2 = mod + 3072, *scale2 = mod + 4096, *gate2 = mod + 5120;

    k_mod<<<6144 / 256, 256, 0, stream>>>(c, w_ada, b_ada, mod);
    k_norm<<<S, 256, 0, stream>>>(x, g1, scale1, shift1, H);
    k_gemm<0><<<dim3(DIN / 64, S / 64), 256, 0, stream>>>(H, D, 0, w_in, DIN, PROJ, DIN, D, nullptr, nullptr);
    k_attn<<<dim3(S / 64, 8), 64, 0, stream>>>(PROJ, relb, H);
    k_attn_combine<<<S, 256, 0, stream>>>(H, lq1, lk1, lq2, lk2, gsub, out);
    float* Ab = H; float* Bb = H + (size_t)S * 512;
    k_lru_gates<<<dim3(S / 16, 8), 64, 0, stream>>>(PROJ, clw, clb, wa, ba, wx, bx, llam, Ab, Bb);
    k_lru_scan<<<512 / 64, 64, 0, stream>>>(Ab, Bb, PROJ, out);
    k_gemm<1><<<dim3(D / 64, S / 64), 256, 0, stream>>>(out, D, 0, w_out, D, H, D, D, x, gate1);
    float* H2 = PROJ; float* UPC = PROJ + (size_t)S * D;
    k_norm<<<S, 256, 0, stream>>>(H, g2, scale2, shift2, H2);
    float* HMC = out;
    for (int cch = 0; cch < 4; ++cch) {
        const int r0 = cch * 4096;
        k_gemm<0><<<dim3(6144 / 64, (4096 + 64) / 64), 256, 0, stream>>>(H2, D, r0 - 2, w_up, 6144, UPC, 6144, D, nullptr, nullptr);
        k_ffn_act<<<(4096 * DFF) / 256, 256, 0, stream>>>(UPC, cfw, cfb, HMC, 4096);
        k_gemm<1><<<dim3(D / 64, 4096 / 64), 256, 0, stream>>>(HMC, DFF, 0, w_down, D, H + (size_t)r0 * D, D, DFF, H + (size_t)r0 * D, gate2);
    }
    k_norm<<<S, 256, 0, stream>>>(H, gfin, nullptr, nullptr, out);
}
```

```cpp
#include <hip/hip_runtime.h>
#include <hip/hip_bf16.h>
#include <cstdio>
#include <cstdint>
#include <cmath>

namespace pg8 {
#define PG8_LAS __attribute__((address_space(3)))
typedef unsigned short bf16_t;
typedef short bf16x8 __attribute__((ext_vector_type(8)));
typedef float f32x4 __attribute__((ext_vector_type(4)));
typedef unsigned u32x4 __attribute__((ext_vector_type(4)));
constexpr int BM = 256, BK = 64, HALF = 128, HTB = HALF * BK * 2  , STAGE_BYTES = 8 * HTB, NXCD = 8, WGM = 8;

__host__ __device__ __forceinline__ int lds_byte(int r, int c) { const int st = (r >> 4) * 2 + (c >> 5), rr = r & 15, cc = c & 31, ob = rr * 64 + cc * 2; return st * 1024 + (ob ^ (((ob >> 9) & 1) << 5)); }
__host__ __device__ __forceinline__ void stage_rc(int b, int& R, int& C) { const int st = b / 1024, sb = b % 1024, swz = sb ^ (((sb >> 9) & 1) << 5); R = (st >> 1) * 16 + swz / 64; C = (st & 1) * 32 + (swz % 64) / 2; }
__host__ __device__ __forceinline__ int perm32(int rho) { const int n = rho >> 4, i = rho & 15; return 8 * (i >> 2) + 4 * n + (i & 3); }

struct Unit { int pm, pn; };
struct Gemm { const bf16_t* A; const bf16_t* Bt; int M, N, K; };

struct StaticOrder {
    int nM, nN, nwg, G, c;
    __host__ __device__ void init(int M, int N, int G_, int c_) { nM = M / BM; nN = N / BM; nwg = nM * nN; G = G_; c = c_; }
    __host__ __device__ bool next(int i, Unit& u) const {
        const long L = (long)i * G + c; if (L >= nwg) return false;
        int wgid = (int)L; { const int q = nwg / NXCD, r = nwg % NXCD, xcd = wgid % NXCD, off = wgid / NXCD; wgid = (xcd < r ? xcd * (q + 1) : r * (q + 1) + (xcd - r) * q) + off; }
        const int nig = WGM * nN, gid = wgid / nig, fm = gid * WGM, gsz = (nM - fm) < WGM ? (nM - fm) : WGM;
        u.pm = fm + ((wgid % nig) % gsz); u.pn = (wgid % nig) / gsz; return true;
    }
    __device__ __forceinline__ void a_ready(const Unit&) const {}
    __device__ __forceinline__ void done(const Unit&) const {}
};

__device__ __forceinline__ unsigned cvt_pk_bf16(float lo, float hi) { unsigned r; asm volatile("v_cvt_pk_bf16_f32 %0, %1, %2" : "=v"(r) : "v"(lo), "v"(hi)); return r; }
typedef float f32x2 __attribute__((ext_vector_type(2)));
__device__ __forceinline__ f32x2 gelu_pk(f32x2 v) {
    const f32x2 av = __builtin_elementwise_abs(v), d = av * 0.2316418882f + 1.0f;
    f32x2 t; t.x = __builtin_amdgcn_rcpf(d.x); t.y = __builtin_amdgcn_rcpf(d.y);
    f32x2 q = t * 0.5307027145f + (-0.7265760135f); q = q * t + 0.7107068705f; q = q * t + (-0.142248368f); q = q * t + 0.127414796f; q = q * t;
    const f32x2 s = (v * v) * (-0.72134752044f);
    f32x2 e; e.x = __builtin_amdgcn_exp2f(s.x); e.y = __builtin_amdgcn_exp2f(s.y);
    const f32x2 m = v * (q * e), r = v - m;
    f32x2 o; o.x = v.x < 0.f ? m.x : r.x; o.y = v.y < 0.f ? m.y : r.y; return o;
}

template <int ACT  > struct EpiBf16 {
    static constexpr bool PERM = true, AFTER_DRAIN = false; static_assert(ACT == 0 || ACT == 1, "EpiBf16: ACT is 0 (none) or 1 (gelu_pk)");
    bf16_t* O; int ldc; const float* bias; int split_cols; size_t split_stride; float scale0;
    __device__ __forceinline__ void operator()(const f32x4 (&acc)[2][2][4][2], const Unit& u, int wr, int wc, int fr, int fq) const {
        const int row0 = u.pm * BM + wr * 64 + fr; int colt = u.pn * BM; bf16_t* base = O;
        float sc = 1.f; if (split_cols) { const int t = colt / split_cols; base += (size_t)t * split_stride; colt -= t * split_cols; if (t == 0) sc = scale0; }
        const int col0 = colt + wc * 32 + 8 * fq, bcol0 = u.pn * BM + wc * 32 + 8 * fq;
        f32x4 bv[2][2];
#pragma unroll
        for (int bj = 0; bj < 2; ++bj)
#pragma unroll
            for (int n = 0; n < 2; ++n) bv[bj][n] = bias ? *(const f32x4*)(bias + bcol0 + bj * HALF + 4 * n) : (f32x4){0.f, 0.f, 0.f, 0.f};
#pragma unroll
        for (int ai = 0; ai < 2; ++ai)
#pragma unroll
            for (int m = 0; m < 4; ++m) { bf16_t* rowp = base + (size_t)(row0 + ai * HALF + m * 16) * ldc + col0;
#pragma unroll
                for (int bj = 0; bj < 2; ++bj) { f32x4 v0 = acc[ai][bj][m][0] + bv[bj][0], v1 = acc[ai][bj][m][1] + bv[bj][1];
                    if (ACT == 1) { f32x2 a = gelu_pk((f32x2){v0[0], v0[1]}), b = gelu_pk((f32x2){v0[2], v0[3]}), c = gelu_pk((f32x2){v1[0], v1[1]}), d = gelu_pk((f32x2){v1[2], v1[3]});
                        v0 = (f32x4){a.x, a.y, b.x, b.y}; v1 = (f32x4){c.x, c.y, d.x, d.y}; }
                    v0 = v0 * sc; v1 = v1 * sc; u32x4 w; w.x = cvt_pk_bf16(v0[0], v0[1]); w.y = cvt_pk_bf16(v0[2], v0[3]); w.z = cvt_pk_bf16(v1[0], v1[1]); w.w = cvt_pk_bf16(v1[2], v1[3]);
                    *(u32x4*)(rowp + bj * HALF) = w; } }
    }
};

struct EpiResGate {
    static constexpr bool PERM = false, AFTER_DRAIN = false;
    const float* base; float* out; int ldc; const float* gate;
    __device__ __forceinline__ void operator()(const f32x4 (&acc)[2][2][4][2], const Unit& u, int wr, int wc, int fr, int fq) const {
        const int col0 = u.pn * BM + wc * 32 + 4 * fq;
        f32x4 gv[2][2];
#pragma unroll
        for (int bj = 0; bj < 2; ++bj)
#pragma unroll
            for (int n = 0; n < 2; ++n) gv[bj][n] = *(const f32x4*)(gate + col0 + bj * HALF + n * 16);
#pragma unroll
        for (int ai = 0; ai < 2; ++ai)
#pragma unroll
            for (int m = 0; m < 4; ++m) { const size_t off = (size_t)(u.pm * BM + ai * HALF + wr * 64 + m * 16 + fr) * ldc + col0;
#pragma unroll
                for (int bj = 0; bj < 2; ++bj)
#pragma unroll
                    for (int n = 0; n < 2; ++n) { const f32x4 bs = *(const f32x4*)(base + off + bj * HALF + n * 16); *(f32x4*)(out + off + bj * HALF + n * 16) = bs + gv[bj][n] * acc[ai][bj][m][n]; } }
    }
};
__device__ __forceinline__ float bf_lo(unsigned w) { return __uint_as_float(w << 16); }
__device__ __forceinline__ float bf_hi(unsigned w) { return __uint_as_float(w & 0xffff0000u); }
__device__ __forceinline__ float gelu_t(float y) { const float t = y * (1.0f + 0.044715f * y * y); const float e = __builtin_amdgcn_exp2f(-2.302208198f * t); return y * __builtin_amdgcn_rcpf(1.0f + e); }
struct EpiConvGate {
    static constexpr bool PERM = true, AFTER_DRAIN = false;
    const bf16_t* Ab; bf16_t* O; int ldc; const float* cw; const float* cb;
    __device__ __forceinline__ void operator()(const f32x4 (&acc)[2][2][4][2], const Unit& u, int wr, int wc, int fr, int fq) const {
        const int row0 = u.pm * BM + wr * 64 + fr, col0 = u.pn * BM + wc * 32 + 8 * fq;
#pragma unroll
        for (int bj = 0; bj < 2; ++bj) { const int c = col0 + bj * HALF;
            f32x4 w0[2], w1[2], w2[2], bb[2];
#pragma unroll
            for (int n = 0; n < 2; ++n) { w0[n] = *(const f32x4*)(cw + c + 4 * n); w1[n] = *(const f32x4*)(cw + ldc + c + 4 * n); w2[n] = *(const f32x4*)(cw + 2 * ldc + c + 4 * n); bb[n] = *(const f32x4*)(cb + c + 4 * n); }
#pragma unroll
            for (int ai = 0; ai < 2; ++ai)
#pragma unroll
                for (int m = 0; m < 4; ++m) { const int r = row0 + ai * HALF + m * 16; const bf16_t* ap = Ab + (size_t)r * ldc + c;
                    const u32x4 a2 = *(const u32x4*)ap; u32x4 a1 = (u32x4){0u, 0u, 0u, 0u}, a0 = (u32x4){0u, 0u, 0u, 0u};
                    if (r >= 1) a1 = *(const u32x4*)(ap - ldc);
                    if (r >= 2) a0 = *(const u32x4*)(ap - 2 * ldc);
                    u32x4 w;
#pragma unroll
                    for (int n = 0; n < 2; ++n) { const f32x4 g = acc[ai][bj][m][n]; float y[4];
                        y[0] = bb[n][0] + w0[n][0] * bf_lo(a0[2 * n]) + w1[n][0] * bf_lo(a1[2 * n]) + w2[n][0] * bf_lo(a2[2 * n]);
                        y[1] = bb[n][1] + w0[n][1] * bf_hi(a0[2 * n]) + w1[n][1] * bf_hi(a1[2 * n]) + w2[n][1] * bf_hi(a2[2 * n]);
                        y[2] = bb[n][2] + w0[n][2] * bf_lo(a0[2 * n + 1]) + w1[n][2] * bf_lo(a1[2 * n + 1]) + w2[n][2] * bf_lo(a2[2 * n + 1]);
                        y[3] = bb[n][3] + w0[n][3] * bf_hi(a0[2 * n + 1]) + w1[n][3] * bf_hi(a1[2 * n + 1]) + w2[n][3] * bf_hi(a2[2 * n + 1]);
                        w[2 * n] = cvt_pk_bf16(gelu_t(y[0]) * g[0], gelu_t(y[1]) * g[1]); w[2 * n + 1] = cvt_pk_bf16(gelu_t(y[2]) * g[2], gelu_t(y[3]) * g[3]); }
                    *(u32x4*)(O + (size_t)r * ldc + c) = w; } }
    }
};

template <class Epi, class Sched, bool ALIGN_EPI = false, bool SP2 = false>
__device__ __forceinline__ void gemm_phase(PG8_LAS unsigned char* lds, const Gemm g, const Sched& S, const Epi& E) {
    int tid_ = threadIdx.x; asm volatile("" : "+v"(tid_));
    const int tid = tid_, wid = __builtin_amdgcn_readfirstlane(tid >> 6), lane = tid & 63, wr = wid >> 2, wc = wid & 3, fr = lane & 15, fq = lane >> 4;
    const int K = g.K, nt = K / BK;
    unsigned voffA[2], voffB[2];
#pragma unroll
    for (int i = 0; i < 2; ++i) { int R, C; stage_rc(tid * 16 + i * 8192, R, C); const int Rb = Epi::PERM ? ((R & ~31) + perm32(R & 31)) : R;
        voffA[i] = (unsigned)(R * K + C) * 2u; voffB[i] = (unsigned)(Rb * K + C) * 2u; }
    const size_t kstep = (size_t)(BK * 2);
    const size_t hstep = (size_t)HALF * K * 2;
    const size_t tstep = 2 * hstep;
    const unsigned ldsw = (unsigned)wid * 1024u;
    const int aoff = lds_byte(wr * 64 + fr, fq * 8), boff = lds_byte(wc * 32 + fr, fq * 8);
#define PG8_SA(b, h) (((b) * 2 + (h)) * HTB)
#define PG8_SB(b, h) ((4 + (b) * 2 + (h)) * HTB)
#define PG8_STAGE(bufoff, gbase, voff) do { _Pragma("unroll") for (int _i = 0; _i < 2; ++_i) \
        __builtin_amdgcn_global_load_lds((const unsigned*)((const char*)(gbase) + (voff)[_i]), (PG8_LAS unsigned*)(lds + (bufoff) + ldsw + _i * 8192), 16, 0, 0); } while (0)
#define PG8_LDA(dst, b, h) do { _Pragma("unroll") for (int m = 0; m < 4; ++m) _Pragma("unroll") for (int k = 0; k < 2; ++k) dst[m][k] = *(const PG8_LAS bf16x8*)(lds + PG8_SA(b, h) + aoff + m * 2048 + k * 1024); } while (0)
#define PG8_LDB(dst, b, h) do { _Pragma("unroll") for (int n = 0; n < 2; ++n) _Pragma("unroll") for (int k = 0; k < 2; ++k) dst[n][k] = *(const PG8_LAS bf16x8*)(lds + PG8_SB(b, h) + boff + n * 2048 + k * 1024); } while (0)
#define PG8_MMA(ai, bj, At, Bt) do { __builtin_amdgcn_s_setprio(1); _Pragma("unroll") for (int m = 0; m < 4; ++m) _Pragma("unroll") for (int n = 0; n < 2; ++n) _Pragma("unroll") for (int k = 0; k < 2; ++k) \
        acc[ai][bj][m][n] = __builtin_amdgcn_mfma_f32_16x16x32_bf16(Bt[n][k], At[m][k], acc[ai][bj][m][n], 0, 0, 0); __builtin_amdgcn_s_setprio(0); } while (0)
#define PG8_WAIT_V(n) asm volatile("s_waitcnt vmcnt(" #n ")" ::: "memory")
#define PG8_WAIT_L(n) asm volatile("s_waitcnt lgkmcnt(" #n ")" ::: "memory")
#define PG8_BAR __builtin_amdgcn_s_barrier()
#define PG8_SCHED __builtin_amdgcn_sched_barrier(0)
    Unit cur, nxt; int ui = 0;
    if (!S.next(0, cur)) return;
    f32x4 acc[2][2][4][2];
#pragma unroll
    for (int a = 0; a < 2; ++a)
#pragma unroll
        for (int b = 0; b < 2; ++b)
#pragma unroll
            for (int m = 0; m < 4; ++m)
#pragma unroll
                for (int n = 0; n < 2; ++n) acc[a][b][m][n] = (f32x4){0.f, 0.f, 0.f, 0.f};
    bf16x8 At[4][2], B0[2][2], B1[2][2];
    const char* cA = (const char*)g.A + (size_t)cur.pm * tstep; const char* cB = (const char*)g.Bt + (size_t)cur.pn * tstep;
    S.a_ready(cur);
    if constexpr (SP2) {
        PG8_STAGE(PG8_SB(0, 0), cB, voffB); PG8_STAGE(PG8_SB(0, 1), cB + hstep, voffB); PG8_STAGE(PG8_SA(0, 0), cA, voffA); PG8_STAGE(PG8_SA(0, 1), cA + hstep, voffA);
        if (wr == 1) PG8_BAR;
        PG8_WAIT_V(2); PG8_BAR;
        PG8_STAGE(PG8_SB(1, 0), cB + kstep, voffB); PG8_STAGE(PG8_SA(1, 0), cA + kstep, voffA); PG8_STAGE(PG8_SB(1, 1), cB + hstep + kstep, voffB);
        PG8_WAIT_V(6); PG8_BAR;
    } else {
        PG8_STAGE(PG8_SB(0, 0), cB, voffB); PG8_STAGE(PG8_SA(0, 0), cA, voffA); PG8_STAGE(PG8_SB(0, 1), cB + hstep, voffB); PG8_STAGE(PG8_SA(0, 1), cA + hstep, voffA);
        if (wr == 1) PG8_BAR;
        PG8_WAIT_V(4); PG8_BAR;
        PG8_STAGE(PG8_SB(1, 0), cB + kstep, voffB); PG8_STAGE(PG8_SA(1, 0), cA + kstep, voffA); PG8_STAGE(PG8_SB(1, 1), cB + hstep + kstep, voffB);
        PG8_WAIT_V(6); PG8_BAR;
    }
    for (;;) {
        const bool has_next = S.next(ui + 1, nxt);
        const char* nA = has_next ? (const char*)g.A + (size_t)nxt.pm * tstep : cA; const char* nB = has_next ? (const char*)g.Bt + (size_t)nxt.pn * tstep : cB;
        for (int t = 0; t < nt; t += 2) {
            const bool last = (t == nt - 2);
            const char* a1 = cA + (size_t)(t + 1) * kstep;
            const char* a2 = last ? nA : cA + (size_t)(t + 2) * kstep; const char* b2 = last ? nB : cB + (size_t)(t + 2) * kstep;
            const char* a3 = a2 + kstep; const char* b3 = b2 + kstep;
            if (last && has_next) S.a_ready(nxt);
            if constexpr (SP2) {
            PG8_LDB(B0, 0, 0); PG8_LDB(B1, 0, 1); PG8_SCHED; PG8_LDA(At, 0, 0); PG8_STAGE(PG8_SA(1, 1), a1 + hstep, voffA);
            PG8_WAIT_V(8); PG8_WAIT_L(0); PG8_BAR; PG8_MMA(0, 0, At, B0); PG8_MMA(0, 1, At, B1); PG8_BAR; PG8_SCHED;
            PG8_LDA(At, 0, 1); PG8_STAGE(PG8_SB(0, 0), b2, voffB); PG8_STAGE(PG8_SB(0, 1), b2 + hstep, voffB); PG8_STAGE(PG8_SA(0, 0), a2, voffA);
            PG8_WAIT_V(8); PG8_WAIT_L(0); PG8_BAR; PG8_MMA(1, 0, At, B0); PG8_MMA(1, 1, At, B1); PG8_BAR; PG8_SCHED;
            PG8_LDB(B0, 1, 0); PG8_LDB(B1, 1, 1); PG8_SCHED; PG8_LDA(At, 1, 0); PG8_STAGE(PG8_SA(0, 1), a2 + hstep, voffA);
            PG8_WAIT_V(8); PG8_WAIT_L(0); PG8_BAR; PG8_MMA(0, 0, At, B0); PG8_MMA(0, 1, At, B1); PG8_BAR; PG8_SCHED;
            PG8_LDA(At, 1, 1); PG8_STAGE(PG8_SB(1, 0), b3, voffB); PG8_STAGE(PG8_SB(1, 1), b3 + hstep, voffB); PG8_STAGE(PG8_SA(1, 0), a3, voffA);
            PG8_WAIT_V(8); PG8_WAIT_L(0); PG8_BAR; PG8_MMA(1, 0, At, B0); PG8_MMA(1, 1, At, B1); PG8_BAR; PG8_SCHED;
            } else {
            PG8_LDB(B0, 0, 0); PG8_SCHED; PG8_LDA(At, 0, 0); PG8_STAGE(PG8_SA(1, 1), a1 + hstep, voffA);
            PG8_WAIT_L(8); PG8_BAR; PG8_WAIT_L(0); PG8_MMA(0, 0, At, B0); PG8_BAR; PG8_SCHED;
            PG8_LDB(B1, 0, 1); PG8_STAGE(PG8_SB(0, 0), b2, voffB);
            PG8_BAR; PG8_WAIT_L(0); PG8_MMA(0, 1, At, B1); PG8_BAR;
            PG8_LDA(At, 0, 1); PG8_STAGE(PG8_SA(0, 0), a2, voffA);
            PG8_BAR; PG8_WAIT_L(0); PG8_MMA(1, 0, At, B0); PG8_BAR; PG8_SCHED;
            PG8_STAGE(PG8_SB(0, 1), b2 + hstep, voffB);
            PG8_WAIT_V(6); PG8_BAR; PG8_MMA(1, 1, At, B1); PG8_BAR;
            PG8_LDB(B0, 1, 0); PG8_SCHED; PG8_LDA(At, 1, 0); PG8_STAGE(PG8_SA(0, 1), a2 + hstep, voffA);
            PG8_WAIT_L(8); PG8_BAR; PG8_WAIT_L(0); PG8_MMA(0, 0, At, B0); PG8_BAR; PG8_SCHED;
            PG8_LDB(B1, 1, 1); PG8_STAGE(PG8_SB(1, 0), b3, voffB);
            PG8_BAR; PG8_WAIT_L(0); PG8_MMA(0, 1, At, B1); PG8_BAR;
            PG8_LDA(At, 1, 1); PG8_STAGE(PG8_SA(1, 0), a3, voffA);
            PG8_BAR; PG8_WAIT_L(0); PG8_MMA(1, 0, At, B0); PG8_BAR; PG8_SCHED;
            PG8_STAGE(PG8_SB(1, 1), b3 + hstep, voffB);
            PG8_WAIT_V(6); PG8_BAR; PG8_MMA(1, 1, At, B1); PG8_BAR;
            }
        }
        if constexpr (ALIGN_EPI) { if (wr == 0) PG8_BAR; }
        if constexpr (!Epi::AFTER_DRAIN) { E(acc, cur, wr, wc, fr, fq); S.done(cur); }
        if (!has_next) break;
#pragma unroll
        for (int a = 0; a < 2; ++a)
#pragma unroll
            for (int b = 0; b < 2; ++b)
#pragma unroll
                for (int m = 0; m < 4; ++m)
#pragma unroll
                    for (int n = 0; n < 2; ++n) acc[a][b][m][n] = (f32x4){0.f, 0.f, 0.f, 0.f};
        cur = nxt; cA = nA; cB = nB; ++ui;
        if constexpr (ALIGN_EPI) { if (wr == 1) PG8_BAR; }
    }
    PG8_WAIT_V(0);
    if constexpr (!ALIGN_EPI) { if (wr == 0) PG8_BAR; }
    PG8_BAR;
    if constexpr (Epi::AFTER_DRAIN) { E.fused(acc, cur, wr, wc, fr, fq, lds, wid, lane); S.done(cur); }
#undef PG8_SA
#undef PG8_SB
#undef PG8_STAGE
#undef PG8_LDA
#undef PG8_LDB
#undef PG8_MMA
#undef PG8_WAIT_V
#undef PG8_WAIT_L
#undef PG8_BAR
#undef PG8_SCHED
}
}

#ifndef PG8_SP2
#define PG8_SP2 true
#endif
#ifndef PG8_ALIGN
#define PG8_ALIGN true
#endif
#include <hip/hip_bf16.h>
#include <cmath>
namespace attn_body {
using bf16=__hip_bfloat16;
using bf16x8=__attribute__((ext_vector_type(8)))short;
using s16x4=__attribute__((ext_vector_type(4)))short;
using f32x16=__attribute__((ext_vector_type(16)))float;
using u32x4=__attribute__((ext_vector_type(4)))unsigned;
constexpr int SEQ=16384,D=64,PQ=512,PO=1024;
constexpr int NW=8,QBLK=32,QB=QBLK*NW,KVBLK=64,NQB=SEQ/QB;
constexpr int ATTN_UNIT_ROWS=QB;
__device__ __forceinline__ int crow(int r,int hi){return (r&3)+8*(r>>2)+4*hi;}
#define SBAR() __builtin_amdgcn_sched_barrier(0)
typedef __attribute__((address_space(3))) const float* lds_fptr;
__device__ __forceinline__ void bmask(f32x16&p0,f32x16&p1,int jb,int qrel,int hi,lds_fptr tb){
  const lds_fptr p=tb+(qrel-64*jb-4*hi+255);
  #pragma unroll
  for(int r=0;r<16;++r){const int o=(r&3)+8*(r>>2); p0[r]+=p[-o]; p1[r]+=p[-o-32];}
}

constexpr int NSLOT=3, SLOTB=8192;
constexpr int LDS_K=0, LDS_V=NSLOT*SLOTB, LDS_WS=2*NSLOT*SLOTB, LDS_OST=LDS_WS+NW*64*4, LDS_BYTES=LDS_OST+NW*4096;
constexpr float C2=0.125f*1.4426950408889634f;
__device__ __forceinline__ void glds16s(const void*gbase,unsigned voff,unsigned lds_dst){unsigned keep;
  asm volatile("s_nop 4\n\ts_mov_b32 %0, m0\n\ts_mov_b32 m0, %2\n\ts_nop 0\n\tglobal_load_lds_dwordx4 %1, %3\n\ts_mov_b32 m0, %0":"=&s"(keep):"v"(voff),"s"(lds_dst),"s"(gbase):"memory");}
__device__ __forceinline__ float max3f(float a,float b,float c){float r;asm("v_max3_f32 %0, %1, %2, %3":"=v"(r):"v"(a),"v"(b),"v"(c));return r;}
__device__ __forceinline__ float max2f(float a,float b){float r;asm("v_max_f32_e32 %0, %1, %2":"=v"(r):"v"(a),"v"(b));return r;}
__device__ __forceinline__ float fadd_s(float a,float b){float r;asm("v_add_f32_e32 %0, %1, %2":"=v"(r):"v"(a),"v"(b));return r;}
__device__ __forceinline__ float fsub_s(float a,float b){float r;asm("v_sub_f32_e32 %0, %1, %2":"=v"(r):"v"(a),"v"(b));return r;}
typedef float f32x2_t __attribute__((ext_vector_type(2))); typedef __bf16 bf16x2_t __attribute__((ext_vector_type(2)));
__device__ __forceinline__ unsigned cvtpk_s(float lo,float hi){f32x2_t v={lo,hi};bf16x2_t b=__builtin_convertvector(v,bf16x2_t);return __builtin_bit_cast(unsigned,b);}
#define WAIT_BAR(N) asm volatile("s_waitcnt vmcnt(" #N ") lgkmcnt(0)\n\ts_barrier":::"memory")

__device__ __forceinline__ void qkt(f32x16&p0,f32x16&p1,const char*Kslot,const bf16x8*qr,const f32x16&negm,int r32,int hi){
  const char*kb=Kslot+hi*1024+r32*16;
  #pragma unroll
  for(int d0=0;d0<4;++d0){
    const bf16x8 b0=*reinterpret_cast<const bf16x8*>(kb+d0*2048);
    const bf16x8 b1=*reinterpret_cast<const bf16x8*>(kb+d0*2048+512);
    if(d0==0){p0=__builtin_amdgcn_mfma_f32_32x32x16_bf16(b0,qr[0],negm,0,0,0);p1=__builtin_amdgcn_mfma_f32_32x32x16_bf16(b1,qr[0],negm,0,0,0);}
    else{p0=__builtin_amdgcn_mfma_f32_32x32x16_bf16(b0,qr[d0],p0,0,0,0);p1=__builtin_amdgcn_mfma_f32_32x32x16_bf16(b1,qr[d0],p1,0,0,0);}}
}
typedef __attribute__((address_space(3))) const char* lds_cptr;
typedef short v4i16_t __attribute__((ext_vector_type(4)));
__device__ __forceinline__ void kload8(bf16x8*kf,lds_cptr kp){
  kf[0]=*(const __attribute__((address_space(3))) bf16x8*)(kp);      kf[1]=*(const __attribute__((address_space(3))) bf16x8*)(kp+512);
  kf[2]=*(const __attribute__((address_space(3))) bf16x8*)(kp+2048); kf[3]=*(const __attribute__((address_space(3))) bf16x8*)(kp+2560);
  kf[4]=*(const __attribute__((address_space(3))) bf16x8*)(kp+4096); kf[5]=*(const __attribute__((address_space(3))) bf16x8*)(kp+4608);
  kf[6]=*(const __attribute__((address_space(3))) bf16x8*)(kp+6144); kf[7]=*(const __attribute__((address_space(3))) bf16x8*)(kp+6656);
}
__device__ __forceinline__ void kload2(bf16x8*kf,lds_cptr kp,int j){ kf[2*j]=*(const __attribute__((address_space(3))) bf16x8*)(kp+j*2048); kf[2*j+1]=*(const __attribute__((address_space(3))) bf16x8*)(kp+j*2048+512); }
__device__ __forceinline__ s16x4 vtr(lds_cptr p){ return __builtin_bit_cast(s16x4,__builtin_amdgcn_ds_read_tr16_b64_v4i16((__attribute__((address_space(3))) v4i16_t*)p)); }
__device__ __forceinline__ float rowmax(const f32x16&p0,const f32x16&p1){
  float a=max3f(p0[0],p0[1],p1[0]),b=max3f(p0[2],p0[3],p1[1]);a=max3f(a,p1[2],p1[3]);
  #pragma unroll
  for(int r=4;r<16;r+=4){a=max3f(a,p0[r],p0[r+1]);b=max3f(b,p0[r+2],p0[r+3]);a=max3f(a,p1[r],p1[r+1]);b=max3f(b,p1[r+2],p1[r+3]);}
  const float m=max2f(a,b);
  auto rr=__builtin_amdgcn_permlane32_swap(__float_as_uint(m),__float_as_uint(m),false,false);
  return max2f(__uint_as_float(rr[0]),__uint_as_float(rr[1]));
}
__device__ __forceinline__ void pv(f32x16*o,int vb,bf16x8 pa0,bf16x8 pa1,bf16x8 pa2,bf16x8 pa3){
  #pragma unroll
  for(int d0=0;d0<2;++d0){s16x4 lo[4],hi[4];
    #pragma unroll
    for(int ks=0;ks<4;++ks){
      asm volatile("ds_read_b64_tr_b16 %0,%1 offset:%c2":"=&v"(lo[ks]):"v"(vb),"i"(d0*4096+ks*1024):"memory");
      asm volatile("ds_read_b64_tr_b16 %0,%1 offset:%c2":"=&v"(hi[ks]):"v"(vb),"i"(d0*4096+ks*1024+512):"memory");}
    asm volatile("s_waitcnt lgkmcnt(0)":::"memory");SBAR();
    #define PK(k) (bf16x8){lo[k][0],lo[k][1],lo[k][2],lo[k][3],hi[k][0],hi[k][1],hi[k][2],hi[k][3]}
    o[d0]=__builtin_amdgcn_mfma_f32_32x32x16_bf16(pa0,PK(0),o[d0],0,0,0);
    o[d0]=__builtin_amdgcn_mfma_f32_32x32x16_bf16(pa1,PK(1),o[d0],0,0,0);
    o[d0]=__builtin_amdgcn_mfma_f32_32x32x16_bf16(pa2,PK(2),o[d0],0,0,0);
    o[d0]=__builtin_amdgcn_mfma_f32_32x32x16_bf16(pa3,PK(3),o[d0],0,0,0);
    #undef PK
  }
}

#ifndef ATTN_STORE16
#define ATTN_STORE16(p,v) (*(u32x4*)(p)=(v))
#endif
template<int THRL> __device__ __forceinline__ void attn_unit(int vh,int qb,const bf16*Q,const bf16*__restrict__ K,const bf16*__restrict__ V,bf16*O,char*shm,lds_fptr tb){
  int tid_=threadIdx.x; asm volatile("":"+v"(tid_));
  const int tid=tid_,lane=tid&63,r32=lane&31,hi=lane>>5; const int wid=__builtin_amdgcn_readfirstlane(tid>>6);
  const long rowbase=0; const int q0=qb*QB; const int hq=vh>>1, hv=((vh>>2)<<1)|(vh&1);
  const bf16*Qw=Q+(rowbase+q0+wid*QBLK)*PQ+hq*D;
  const bf16*Kh=K+rowbase*PQ+hq*D,*Vh=V+rowbase*PQ+hv*D;
  const unsigned lds0=(unsigned)(uintptr_t)shm;
  float*wsf=(float*)(shm+LDS_WS)+wid*64;
  const unsigned kvo=(unsigned)(lane*PQ+wid*8)*2u;
  const unsigned vvo=(unsigned)((16*(wid&3)+(lane>>2))*PQ+(wid>>2)*32+(lane&3)*8)*2u;
  const unsigned kdst=lds0+LDS_K+wid*1024, vdst=lds0+LDS_V+wid*1024;
  #define DMA_K(t,slot) glds16s(Kh+(long)(t)*KVBLK*PQ,kvo,(unsigned)__builtin_amdgcn_readfirstlane(kdst+(slot)))
  #define DMA_V(t,slot) glds16s(Vh+(long)(t)*KVBLK*PQ,vvo,(unsigned)__builtin_amdgcn_readfirstlane(vdst+(slot)))
  const char*Kbase=shm+LDS_K; bf16x8 kf[8];
  const lds_cptr shm3=(lds_cptr)shm; const lds_cptr kp0=shm3+LDS_K+hi*1024+r32*16; const lds_cptr vp0=shm3+LDS_V+((lane>>4)&1)*32+(lane&3)*8+(4*hi+((lane&15)>>2))*64;
  const int NT=(q0+QB)/KVBLK;
  DMA_K(0,0);DMA_V(0,0);DMA_K(1,SLOTB);
  bf16x8 qr[4];
  #pragma unroll
  for(int d0=0;d0<4;++d0)qr[d0]=*reinterpret_cast<const bf16x8*>(&Qw[(long)r32*PQ+d0*16+hi*8]);
  float mhat=0.f,l_reg=0.f;f32x16 o[2];o[0]=f32x16{};o[1]=f32x16{};f32x16 negm=f32x16{};asm volatile("":"+v"(negm));
  const int qrel=wid*QBLK+r32;
  #define CMASK(P0,P1,t) do{int jb_=(t)-(NT-4); if(jb_>=-2)bmask(P0,P1,jb_,qrel,hi,tb);}while(0)
  bool resc=false;
  #define START(P0,P1) do{ const float rm=rowmax(P0,P1); resc=false; \
    { const float dl=rm; mhat=fadd_s(mhat,dl); \
      _Pragma("unroll") for(int r=0;r<16;++r){P0[r]=fsub_s(P0[r],dl);P1[r]=fsub_s(P1[r],dl);} \
      _Pragma("unroll") for(int r=0;r<16;++r)negm[r]=-mhat; asm volatile("":"+v"(negm)); } \
    _Pragma("unroll") for(int r=0;r<16;++r)P0[r]=__builtin_amdgcn_exp2f(P0[r]); }while(0)
  #define RESC() do{ if(resc){ asm volatile("s_waitcnt lgkmcnt(0)":::"memory"); \
      _Pragma("unroll") for(int d_=0;d_<2;++d_) _Pragma("unroll") for(int r=0;r<16;++r)o[d_][r]*=wsf[crow(r,hi)]; } }while(0)
  f32x16 pA0,pA1,pB0,pB1;
  int sl_prev=0,sl_cur=0,sl_next=SLOTB;
  #define ROT() do{sl_prev=sl_cur;sl_cur=sl_next;sl_next=(sl_next==(NSLOT-1)*SLOTB)?0:sl_next+SLOTB;}while(0)
  DMA_K(2,2*SLOTB);
  WAIT_BAR(3);
  qkt(pA0,pA1,Kbase,qr,negm,r32,hi);asm volatile("s_nop 15\n\ts_nop 7":"+v"(pA0),"+v"(pA1));CMASK(pA0,pA1,0);
  START(pA0,pA1);
  _Pragma("unroll") for(int r=0;r<16;++r)pA1[r]=__builtin_amdgcn_exp2f(pA1[r]);
  WAIT_BAR(0);
  DMA_K(3,0);DMA_V(1,SLOTB);
  ROT();
  kload8(kf,kp0+sl_cur);
  WAIT_BAR(2);
  s16x4 vlo[8],vhi[8]; u32x4 pw0,pw1,pw2,pw3;
  #define PKW(P,B) cvtpk_s(P[B],P[B+1])
  #define PAF(k) __builtin_bit_cast(bf16x8,pw##k)
  #define VFR(i) (bf16x8){vlo[i][0],vlo[i][1],vlo[i][2],vlo[i][3],vhi[i][0],vhi[i][1],vhi[i][2],vhi[i][3]}
  #define PIN(x) asm volatile("":"+v"(x))
  #define MX3(a,b,c) __builtin_fmaxf(__builtin_fmaxf((a),(b)),(c))
  #define GAPA(MF,A0,A1,A2,A3,W0,W1,PW) do{ MF; sacc+=A0; sacc+=A1; sacc+=A2; sacc+=A3; PIN(sacc); W0; W1; PIN(PW); SBAR(); }while(0)
  #define EX(v) __builtin_amdgcn_exp2f(v)
  #define GAPB(MF,X,B) do{ MF; X[B]=EX(X[B]); X[B+1]=EX(X[B+1]); X[B+2]=EX(X[B+2]); X[B+3]=EX(X[B+3]); PIN(X); SBAR(); }while(0)
  #define VRD(i) do{ vlo[i]=vtr(vp_+(((i)>>2)*4096+((i)&3)*1024)); vhi[i]=vtr(vp_+(((i)>>2)*4096+((i)&3)*1024+512)); }while(0)
  #define KRD(G,j) do{ if(G){ kload2(kf,kp0+sl_next,j); SBAR(); } }while(0)
  #define STEP(C0,C1,P0,P1,t,GK,GV,GL) do{ SBAR(); \
    const lds_cptr vp_=vp0+sl_prev; \
    VRD(0); SBAR(); float sacc=(P0[0]+P0[1]); \
    GAPA(C0=__builtin_amdgcn_mfma_f32_32x32x16_bf16(kf[0],qr[0],negm,0,0,0), P0[2],P0[3],P0[4],P0[5],     pw0[0]=PKW(P0,0), pw0[1]=PKW(P0,2), pw0); \
    VRD(4); SBAR(); GAPA(C1=__builtin_amdgcn_mfma_f32_32x32x16_bf16(kf[1],qr[0],negm,0,0,0), P0[6],P0[7],P0[8],P0[9],     pw0[2]=PKW(P0,4), pw0[3]=PKW(P0,6), pw0); \
    VRD(1); SBAR(); GAPA(C0=__builtin_amdgcn_mfma_f32_32x32x16_bf16(kf[2],qr[1],C0,0,0,0),   P0[10],P0[11],P0[12],P0[13], pw1[0]=PKW(P0,8), pw1[1]=PKW(P0,10), pw1); \
    VRD(5); SBAR(); GAPA(C1=__builtin_amdgcn_mfma_f32_32x32x16_bf16(kf[3],qr[1],C1,0,0,0),   P0[14],P0[15],P1[0],P1[1],   pw1[2]=PKW(P0,12),pw1[3]=PKW(P0,14), pw1); \
    VRD(2); SBAR(); GAPA(C0=__builtin_amdgcn_mfma_f32_32x32x16_bf16(kf[4],qr[2],C0,0,0,0),   P1[2],P1[3],P1[4],P1[5],     pw2[0]=PKW(P1,0), pw2[1]=PKW(P1,2), pw2); \
    VRD(6); SBAR(); GAPA(C1=__builtin_amdgcn_mfma_f32_32x32x16_bf16(kf[5],qr[2],C1,0,0,0),   P1[6],P1[7],P1[8],P1[9],     pw2[2]=PKW(P1,4), pw2[3]=PKW(P1,6), pw2); \
    VRD(3); SBAR(); GAPA(C0=__builtin_amdgcn_mfma_f32_32x32x16_bf16(kf[6],qr[3],C0,0,0,0),   P1[10],P1[11],P1[12],P1[13], pw3[0]=PKW(P1,8), pw3[1]=PKW(P1,10), pw3); \
    VRD(7); SBAR(); GAPA(C1=__builtin_amdgcn_mfma_f32_32x32x16_bf16(kf[7],qr[3],C1,0,0,0),   P1[14],P1[15],0.f,0.f,       pw3[2]=PKW(P1,12),pw3[3]=PKW(P1,14), pw3); \
    l_reg+=sacc; \
    if(GK){DMA_K((t)+3,sl_cur);} if(GV){DMA_V((t)+1,sl_next);} \
    CMASK(C0,C1,t); \
    { float a=MX3(C0[0],C0[1],C1[0]),b=MX3(C0[2],C0[3],C1[1]); a=MX3(a,C1[2],C1[3]); \
      _Pragma("unroll") for(int r=4;r<16;r+=4){a=MX3(a,C0[r],C0[r+1]);b=MX3(b,C0[r+2],C0[r+3]);a=MX3(a,C1[r],C1[r+1]);b=MX3(b,C1[r+2],C1[r+3]);} \
      float rm=__builtin_fmaxf(a,b); { auto rr=__builtin_amdgcn_permlane32_swap(__float_as_uint(rm),__float_as_uint(rm),false,false); rm=__builtin_fmaxf(__uint_as_float(rr[0]),__uint_as_float(rr[1])); } \
      resc=false; \
      if(__builtin_expect(__any(rm>(float)THRL),0)){ const float dl=__builtin_fmaxf(rm,0.f); mhat+=dl; \
        _Pragma("unroll") for(int r=0;r<16;++r){C0[r]-=dl;C1[r]-=dl;} \
        _Pragma("unroll") for(int r=0;r<16;++r)negm[r]=-mhat; asm volatile("":"+v"(negm)); \
        const float f=__builtin_amdgcn_exp2f(-dl); l_reg*=f; if(hi==0)wsf[r32]=f; resc=true; } } \
    SBAR(); \
    GAPB(o[0]=__builtin_amdgcn_mfma_f32_32x32x16_bf16(PAF(0),VFR(0),o[0],0,0,0), C0,0); \
    GAPB(o[1]=__builtin_amdgcn_mfma_f32_32x32x16_bf16(PAF(0),VFR(4),o[1],0,0,0), C0,4); \
    KRD(GL,0); GAPB(o[0]=__builtin_amdgcn_mfma_f32_32x32x16_bf16(PAF(1),VFR(1),o[0],0,0,0), C0,8); \
    KRD(GL,1); GAPB(o[1]=__builtin_amdgcn_mfma_f32_32x32x16_bf16(PAF(1),VFR(5),o[1],0,0,0), C0,12); \
    KRD(GL,2); GAPB(o[0]=__builtin_amdgcn_mfma_f32_32x32x16_bf16(PAF(2),VFR(2),o[0],0,0,0), C1,0); \
    KRD(GL,3); GAPB(o[1]=__builtin_amdgcn_mfma_f32_32x32x16_bf16(PAF(2),VFR(6),o[1],0,0,0), C1,4); \
    GAPB(o[0]=__builtin_amdgcn_mfma_f32_32x32x16_bf16(PAF(3),VFR(3),o[0],0,0,0), C1,8); \
    GAPB(o[1]=__builtin_amdgcn_mfma_f32_32x32x16_bf16(PAF(3),VFR(7),o[1],0,0,0), C1,12); \
    }while(0)
  int t=1;
  #undef CMASK
  #define CMASK(P0,P1,t) do{}while(0)
  for(;t+7<NT;t+=2){
    STEP(pB0,pB1,pA0,pA1,t,true,true,true);     WAIT_BAR(2); RESC(); ROT();
    STEP(pA0,pA1,pB0,pB1,t+1,true,true,true);   WAIT_BAR(2); RESC(); ROT();
  }
  #undef CMASK
  #define CMASK(P0,P1,t) do{int jb_=(t)-(NT-4); if(jb_>=-2)bmask(P0,P1,jb_,qrel,hi,tb);}while(0)
  #define ENDW(tt) do{ if((tt)+3<NT){WAIT_BAR(2);} else if((tt)+2<NT){WAIT_BAR(1);} else {WAIT_BAR(0);} }while(0)
  for(;t+1<NT;t+=2){
    STEP(pB0,pB1,pA0,pA1,t,(t+3<NT),(t+1<NT),(t+1<NT));       ENDW(t);   RESC(); ROT();
    STEP(pA0,pA1,pB0,pB1,t+1,(t+4<NT),(t+2<NT),(t+2<NT));     ENDW(t+1); RESC(); ROT();
  }
  STEP(pB0,pB1,pA0,pA1,NT-1,false,false,false); RESC();
  { float sacc=pB0[0]+pB0[1]; _Pragma("unroll") for(int r=2;r<16;++r)sacc+=pB0[r]; _Pragma("unroll") for(int r=0;r<16;++r)sacc+=pB1[r]; l_reg+=sacc;
    pw0=(u32x4){PKW(pB0,0),PKW(pB0,2),PKW(pB0,4),PKW(pB0,6)};pw1=(u32x4){PKW(pB0,8),PKW(pB0,10),PKW(pB0,12),PKW(pB0,14)};pw2=(u32x4){PKW(pB1,0),PKW(pB1,2),PKW(pB1,4),PKW(pB1,6)};pw3=(u32x4){PKW(pB1,8),PKW(pB1,10),PKW(pB1,12),PKW(pB1,14)};
    SBAR(); pv(o,(int)(unsigned)(uintptr_t)(vp0+sl_cur),PAF(0),PAF(1),PAF(2),PAF(3)); }
  #undef PKW
  #undef PAF
  #undef VFR
  #undef PIN
  #undef MX3
  #undef GAPA
  #undef GAPB
  #undef EX
  #undef VRD
  #undef KRD
  #undef STEP
  #undef ENDW
  {auto rr=__builtin_amdgcn_permlane32_swap(__float_as_uint(l_reg),__float_as_uint(l_reg),false,false);l_reg=__uint_as_float(rr[0])+__uint_as_float(rr[1]);}
  if(hi==0)wsf[32+r32]=l_reg;asm volatile("s_waitcnt lgkmcnt(0)":::"memory");
  float rli[16];
  #pragma unroll
  for(int r=0;r<16;++r)rli[r]=__builtin_amdgcn_rcpf(wsf[32+crow(r,hi)]);
  bf16*Ow=O+(rowbase+q0+wid*QBLK)*PO+vh*D;
  { bf16*stg=(bf16*)(shm+LDS_OST)+wid*2048;
    #pragma unroll
    for(int r=0;r<16;++r){const int orow=crow(r,hi);
      #pragma unroll
      for(int d0=0;d0<2;++d0)stg[orow*64+d0*32+r32]=__float2bfloat16(o[d0][r]*rli[r]);}
    asm volatile("s_waitcnt lgkmcnt(0)":::"memory");
    #pragma unroll
    for(int i=0;i<4;++i){const int row=i*8+(lane>>3),ch=lane&7; const u32x4 v=*(const u32x4*)(stg+row*64+ch*8); ATTN_STORE16(Ow+(long)row*PO+ch*8,v);} }
  asm volatile("s_waitcnt lgkmcnt(0)\n\ts_barrier":::"memory");
  #undef DMA_K
  #undef DMA_V
  #undef CMASK
  #undef START
  #undef RESC
  #undef ROT
}
constexpr int ATTN_LDS_BYTES=LDS_BYTES;
struct AttnTensors { const bf16* Q; const bf16* K; const bf16* V; bf16* O; };
struct AttnUnit { int vh; int qb; };
struct StaticOrder {
  int vcu;
  __device__ __forceinline__ explicit StaticOrder(int grid,int block):vcu((block%8)*(grid/8)+block/8){}
  __device__ __forceinline__ bool next(int i,AttnUnit&u)const{ if(i>=4)return false; const int s=vcu&15; u.vh=vcu>>4; u.qb=(i==0)?s:(i==1)?31-s:(i==2)?32+s:63-s; return true; }
  __device__ __forceinline__ void a_ready(const AttnUnit&)const{}
  __device__ __forceinline__ void done(const AttnUnit&)const{}
};
template<class Sched,int THRL=8> __device__ __forceinline__ void attn_phase(char*lds,const AttnTensors&T,const Sched&S,lds_fptr tbl){
  AttnUnit u;
  for(int i=0;S.next(i,u);++i){ S.a_ready(u); attn_unit<THRL>(u.vh,u.qb,T.Q,T.K,T.V,T.O,lds,tbl+(u.vh>>2)*640); S.done(u); }
}
#undef SBAR
#undef WAIT_BAR
}
#define GAS __attribute__((address_space(1)))
#define LAS __attribute__((address_space(3)))
typedef unsigned short bf16;
typedef unsigned v4u __attribute__((ext_vector_type(4)));
typedef float f32x4 __attribute__((ext_vector_type(4)));
typedef short bf16x8 __attribute__((ext_vector_type(8)));
typedef GAS unsigned gu32;
typedef GAS unsigned long long gu64;
#define RLX_AGENT __ATOMIC_RELAXED, __HIP_MEMORY_SCOPE_AGENT
#define LDS_WAIT() asm volatile("s_waitcnt lgkmcnt(0)" ::: "memory")
#define VM_WAIT() asm volatile("s_waitcnt vmcnt(0)" ::: "memory")
__device__ __forceinline__ unsigned long long rt() { return __builtin_amdgcn_s_memrealtime(); }
__device__ __forceinline__ unsigned f2bf(float f) { unsigned u = __builtin_bit_cast(unsigned, f); return (u + 0x7fffu + ((u >> 16) & 1u)) >> 16; }
__device__ __forceinline__ unsigned pk2(float lo, float hi) { return f2bf(lo) | (f2bf(hi) << 16); }

#define XB_TMO      128
#define XB_XCNT(j)  (256  + 64 * (j))
#define XB_XSUB(j)  (1280 + 64 * (j))
#define XB_XGEN(j)  (2304 + 64 * (j))
#define XB_TOP      3328
#define XB_TOPGEN   3392
#define XCD_BAR_WORDS 3456
#define XB_SPIN_CAP (1u << 18)

__device__ __forceinline__ unsigned xb_ld(unsigned* p)              { return __hip_atomic_load(p, __ATOMIC_RELAXED, __HIP_MEMORY_SCOPE_AGENT); }
__device__ __forceinline__ unsigned xb_add(unsigned* p, unsigned v) { return __hip_atomic_fetch_add(p, v, __ATOMIC_RELAXED, __HIP_MEMORY_SCOPE_AGENT); }
__device__ __forceinline__ unsigned xb_xcc_id() { return (unsigned)__builtin_amdgcn_s_getreg((3 << 11) | 20) & 0xFu; }
#define XB_SPIN(cond, bar) do { unsigned _sp = 0; while (cond) { __builtin_amdgcn_s_sleep(1); \
    if ((++_sp & 255u) == 0u) { if (xb_ld(&(bar)[XB_TMO])) break; if (_sp > XB_SPIN_CAP) { atomicAdd(&(bar)[XB_TMO], 1u); break; } } } } while (0)

struct XcdBarrier {
    unsigned* bar; unsigned x;
    volatile LAS unsigned* st;
};

__device__ __forceinline__ XcdBarrier xcd_barrier_post(unsigned* bar, volatile LAS unsigned* st) {
    XcdBarrier b; b.bar = bar; b.x = xb_xcc_id(); b.st = st;
    if (threadIdx.x == 0) (void)xb_add(&bar[XB_XCNT(b.x)], 1u);
    return b;
}
__device__ __forceinline__ void xcd_barrier_complete(unsigned* bar, unsigned x, unsigned& nloc, unsigned& nx) {
    const unsigned G = gridDim.x * gridDim.y * gridDim.z;
    unsigned sum, cnt, mine, sp = 0u;
    for (;;) {
        sum = 0u; cnt = 0u; mine = 0u;
#pragma unroll
        for (unsigned j = 0; j < 16; ++j) { const unsigned c = xb_ld(&bar[XB_XCNT(j)]); sum += c; cnt += (c > 0u) ? 1u : 0u; mine = (j == x) ? c : mine; }
        if (sum == G) break;
        __builtin_amdgcn_s_sleep(1);
        if ((++sp & 255u) == 0u) { if (xb_ld(&bar[XB_TMO])) break; if (sp > XB_SPIN_CAP) { atomicAdd(&bar[XB_TMO], 1u); break; } }
    }
    nloc = mine > 0u ? mine : 1u; nx = cnt > 0u ? cnt : 1u;
}

__device__ __forceinline__ void xcd_barrier(const XcdBarrier& b) {
    asm volatile("s_waitcnt vmcnt(0)" ::: "memory");
    __syncthreads();
    if (threadIdx.x == 0) {
        unsigned* bar = b.bar;
        __builtin_amdgcn_s_waitcnt(0);
        unsigned nloc = b.st[0], nx = b.st[1];
        if (nloc == 0u) { xcd_barrier_complete(bar, b.x, nloc, nx); b.st[0] = nloc; b.st[1] = nx; }
        const unsigned old = xb_add(&bar[XB_XSUB(b.x)], 1u);
        const unsigned gen = old / nloc;
        if (old + 1u == (gen + 1u) * nloc) {
            __builtin_amdgcn_fence(__ATOMIC_RELEASE, "agent");
            asm volatile("s_waitcnt vmcnt(0)" ::: "memory");
            const unsigned og = xb_add(&bar[XB_TOP], 1u);
            const unsigned tg = og / nx;
            if (og + 1u == (tg + 1u) * nx) xb_add(&bar[XB_TOPGEN], 1u);
            else XB_SPIN(xb_ld(&bar[XB_TOPGEN]) == tg, bar);
            __builtin_amdgcn_fence(__ATOMIC_ACQUIRE, "agent");
            xb_add(&bar[XB_XGEN(b.x)], 1u);
            asm volatile("s_waitcnt vmcnt(0)" ::: "memory");
        } else {
            XB_SPIN(xb_ld(&bar[XB_XGEN(b.x)]) == gen, bar);
            __builtin_amdgcn_fence(__ATOMIC_ACQUIRE, "agent");
            asm volatile("s_waitcnt vmcnt(0)" ::: "memory");
        }
    }
    __syncthreads();
}
constexpr int NWAVES = 8;
constexpr int M = 16384, D = 1024, DIN = 2560, DFF = 3072, NMOD = 6144;
constexpr float EPS = 1e-6f;
constexpr int LCH = 64, NCH = M / LCH;

constexpr size_t MiB = 1u << 20;
constexpr size_t WS_CTL = 0, CTL_ZERO_BYTES = 64 * 1024;
constexpr size_t WS_MOD = 1 * MiB;
constexpr size_t WS_MODP = WS_MOD + 64 * 1024;
constexpr size_t WS_AGG = WS_MOD + 512 * 1024;
constexpr size_t WS_WIN = 2 * MiB, WS_WOUT = 7 * MiB, WS_WUP = 9 * MiB, WS_WDN = 21 * MiB;
constexpr size_t WS_XN = 27 * MiB;
constexpr size_t WS_Q = 59 * MiB, WS_K = 75 * MiB, WS_V = 91 * MiB, WS_XR = 107 * MiB, WS_YG = 123 * MiB;
constexpr size_t WS_OM = 139 * MiB;
constexpr size_t WS_LA = 171 * MiB, WS_LB = 203 * MiB;
constexpr size_t WS_MIX = 59 * MiB;
constexpr size_t WS_AB = 59 * MiB, WS_HM = 155 * MiB;
constexpr size_t WS_END = 251 * MiB;
static_assert(WS_LB + 32 * MiB <= WS_END && WS_HM + 96 * MiB <= WS_END && WS_AB + 96 * MiB <= WS_HM, "d_ws map");
constexpr int CW_BAR = 1024;
constexpr int RING_OFF = 0, RING_BYTES = 131072;
constexpr int TBL_OFF = 98304;
constexpr int LDSCTL_OFF = RING_BYTES, MISC_OFF = LDSCTL_OFF + 320;
constexpr int LDS_BYTES = 147456;
static_assert(MISC_OFF + 128 <= LDS_BYTES && attn_body::LDS_BYTES <= TBL_OFF && TBL_OFF + 4 * 640 * 4 <= RING_BYTES, "LDS map");

struct Args { const float* in[26]; float* out; unsigned char* ws; };
struct Frame {
    LAS unsigned char* lds;
    volatile LAS unsigned* MISC;
    int tid, lane, wave;
    int vcu, G;
};
enum { I_X = 0, I_C, I_WADA, I_BADA, I_G1, I_WIN, I_CLW, I_CLB, I_WA, I_BA, I_WX, I_BX, I_LLAM, I_LQ1, I_LK1, I_LQ2, I_LK2, I_GSUB, I_WOUT, I_G2, I_WUP, I_CFW, I_CFB, I_WDN, I_RELB, I_GFIN };
#define WSF(off) ((float*)(args.ws + (off)))
#define WSB(off) ((bf16*)(args.ws + (off)))

__device__ __forceinline__ float wave_sum(float v) {
#pragma unroll
    for (int o = 1; o < 64; o <<= 1) v += __shfl_xor(v, o);
    return v;
}
__device__ __forceinline__ float bf2f(bf16 v) { return __uint_as_float((unsigned)v << 16); }
__device__ __forceinline__ float gelu_tanh_f(float y) { const float t = y * (1.0f + 0.044715f * y * y); const float e = __builtin_amdgcn_exp2f(-2.302208198f * t); return y * __builtin_amdgcn_rcpf(1.0f + e); }
__device__ __forceinline__ int t5_bucket(int n) {
    if (n < 16) return n;
    const int v = 16 + (int)(logf((float)n / 16.f) / logf(8.f) * 16.f);
    return v < 31 ? v : 31;
}

__device__ __forceinline__ void p0_transpose_item(const float* W, int K, int N, bf16* WT, LAS float* scr, int item, int lane) {
    const int nblk = N / 32, kb = item / nblk, nb = item % nblk, k0 = 64 * kb, n0 = 32 * nb;
#pragma unroll 8
    for (int i = 0; i < 32; ++i) { const int kk = 2 * i + (lane >> 5); scr[kk * 33 + (lane & 31)] = W[(size_t)(k0 + kk) * N + n0 + (lane & 31)]; }
    LDS_WAIT(); asm volatile("" ::: "memory");
    const int c = lane & 7;
#pragma unroll
    for (int j = 0; j < 4; ++j) { const int n = (lane >> 3) + 8 * j; const LAS float* s = scr + (8 * c) * 33 + n;
        v4u o; o.x = pk2(s[0 * 33], s[1 * 33]); o.y = pk2(s[2 * 33], s[3 * 33]); o.z = pk2(s[4 * 33], s[5 * 33]); o.w = pk2(s[6 * 33], s[7 * 33]);
        *(GAS v4u*)(WT + (size_t)(n0 + n) * K + k0 + 8 * c) = o; }
    LDS_WAIT(); asm volatile("" ::: "memory");
}
__device__ __forceinline__ void p0a_prologue(Frame& F, const Args& args) {
    LAS float* scr = (LAS float*)(F.lds + RING_OFF + F.wave * 16384);
    const int gw = F.vcu * NWAVES + F.wave, NGW = F.G * NWAVES;
    for (int it = gw; it < 24 * 16; it += NGW) {
        const int cc = it % 24, kc = it / 24; const int col = cc * 256 + F.lane * 4;
        f32x4 acc = (f32x4){0.f, 0.f, 0.f, 0.f};
        if (kc == 0) acc = *(const f32x4*)(args.in[I_BADA] + col);
#pragma unroll 8
        for (int k = 0; k < 64; ++k) { const int kk = kc * 64 + k; const float cv = args.in[I_C][kk]; const float sv = cv / (1.f + expf(-cv));
            const f32x4 w = *(const f32x4*)(args.in[I_WADA] + (size_t)kk * NMOD + col); acc += w * sv; }
        *(f32x4*)(WSF(WS_MODP) + (size_t)kc * NMOD + col) = acc;
    }
    constexpr int I_IN = (D / 64) * (DIN / 32), I_OUT = (D / 64) * (D / 32), I_UP = (D / 64) * (2 * DFF / 32), I_DN = (DFF / 64) * (D / 32);
    constexpr int NITEMS = I_IN + I_OUT + I_UP + I_DN;
    for (int it = gw; it < NITEMS; it += NGW) {
        int r = it;
        if (r < I_IN) { p0_transpose_item(args.in[I_WIN], D, DIN, WSB(WS_WIN), scr, r, F.lane); continue; } r -= I_IN;
        if (r < I_OUT) { p0_transpose_item(args.in[I_WOUT], D, D, WSB(WS_WOUT), scr, r, F.lane); continue; } r -= I_OUT;
        if (r < I_UP) { p0_transpose_item(args.in[I_WUP], D, 2 * DFF, WSB(WS_WUP), scr, r, F.lane); continue; } r -= I_UP;
        p0_transpose_item(args.in[I_WDN], DFF, D, WSB(WS_WDN), scr, r, F.lane);
    }
}
__device__ __forceinline__ void norm_rows_bf16(Frame& F, const float* X, bf16* XN, const LAS float* U, const LAS float* SH) {
    const int gw = F.vcu * NWAVES + F.wave, NGW = F.G * NWAVES;
    f32x4 u[4], s[4];
#pragma unroll
    for (int j = 0; j < 4; ++j) { u[j] = *(const LAS f32x4*)(U + 256 * j + 4 * F.lane); s[j] = *(const LAS f32x4*)(SH + 256 * j + 4 * F.lane); }
    for (int m = gw; m < M; m += NGW) {
        const GAS f32x4* xr = (const GAS f32x4*)(X + (size_t)m * D) + F.lane;
        f32x4 v[4]; float ss = 0.f;
#pragma unroll
        for (int j = 0; j < 4; ++j) { v[j] = xr[64 * j]; ss += (v[j].x * v[j].x + v[j].y * v[j].y) + (v[j].z * v[j].z + v[j].w * v[j].w); }
        const float rstd = 1.f / sqrtf(wave_sum(ss) * (1.f / D) + EPS);
        GAS unsigned long long* o8 = (GAS unsigned long long*)(XN + (size_t)m * D) + F.lane;
#pragma unroll
        for (int j = 0; j < 4; ++j) { const f32x4 o = v[j] * rstd * u[j] + s[j];
            o8[64 * j] = (unsigned long long)pk2(o.x, o.y) | ((unsigned long long)pk2(o.z, o.w) << 32); }
    }
}
__device__ __forceinline__ void build_mod_tables(Frame& F, const Args& args, const float* g, int scale_off, int shift_off, bool from_partials, LAS float* U, LAS float* SH) {
    for (int cidx = F.tid; cidx < D; cidx += NWAVES * 64) {
        float sc = 0.f, sh = 0.f;
        if (from_partials) { for (int kc = 0; kc < 16; ++kc) { sc += WSF(WS_MODP)[(size_t)kc * NMOD + scale_off + cidx]; sh += WSF(WS_MODP)[(size_t)kc * NMOD + shift_off + cidx]; } }
        else { sc = WSF(WS_MOD)[scale_off + cidx]; sh = WSF(WS_MOD)[shift_off + cidx]; }
        U[cidx] = g[cidx] * (1.f + sc); SH[cidx] = sh;
    }
    __syncthreads();
}
__device__ __forceinline__ void final_norm_rows(Frame& F, float* X, const float* g) {
    const int gw = F.vcu * NWAVES + F.wave, NGW = F.G * NWAVES;
    f32x4 u[4];
#pragma unroll
    for (int j = 0; j < 4; ++j) u[j] = *(const f32x4*)(g + 256 * j + 4 * F.lane);
    for (int m = gw; m < M; m += NGW) {
        GAS f32x4* xr = (GAS f32x4*)(X + (size_t)m * D) + F.lane;
        f32x4 v[4]; float ss = 0.f;
#pragma unroll
        for (int j = 0; j < 4; ++j) { v[j] = xr[64 * j]; ss += (v[j].x * v[j].x + v[j].y * v[j].y) + (v[j].z * v[j].z + v[j].w * v[j].w); }
        const float rstd = 1.f / sqrtf(wave_sum(ss) * (1.f / D) + EPS);
#pragma unroll
        for (int j = 0; j < 4; ++j) xr[64 * j] = v[j] * rstd * u[j];
    }
}
__device__ __forceinline__ void lru_local(Frame& F, const Args& args, int chunk) {
    const int d = F.tid, n = d >> 6, dl = d & 63;
    LAS float* xcs = (LAS float*)(F.lds + RING_OFF);
    const float cw0 = args.in[I_CLW][d], cw1 = args.in[I_CLW][512 + d], cw2 = args.in[I_CLW][1024 + d], cw3 = args.in[I_CLW][1536 + d], cbb = args.in[I_CLB][d];
    const float bav = args.in[I_BA][d], bxv = args.in[I_BX][d];
    const float sp = log1pf(expf(-args.in[I_LLAM][d]));
    const int t0 = chunk * LCH;
    const bf16* XR = WSB(WS_XR);
    float x3 = 0.f, x2 = 0.f, x1 = 0.f;
    if (t0 >= 3) { x3 = bf2f(XR[(size_t)(t0 - 3) * 512 + d]); x2 = bf2f(XR[(size_t)(t0 - 2) * 512 + d]); x1 = bf2f(XR[(size_t)(t0 - 1) * 512 + d]); }
    float h = 0.f, cum = 1.f;
#pragma unroll 1
    for (int sub = 0; sub < LCH / 16; ++sub) {
        float xc[16], ra[16], ri[16];
#pragma unroll
        for (int i = 0; i < 16; ++i) { const float x0 = bf2f(XR[(size_t)(t0 + sub * 16 + i) * 512 + d]); xc[i] = cbb + cw0 * x3 + cw1 * x2 + cw2 * x1 + cw3 * x0; x3 = x2; x2 = x1; x1 = x0; xcs[i * 512 + d] = xc[i]; ra[i] = bav; ri[i] = bxv; }
        __syncthreads();
#pragma unroll 1
        for (int c0 = 0; c0 < 64; c0 += 16) {
            float wq[16], wv[16];
#pragma unroll
            for (int cc = 0; cc < 16; ++cc) { wq[cc] = args.in[I_WA][n * 4096 + (c0 + cc) * 64 + dl]; wv[cc] = args.in[I_WX][n * 4096 + (c0 + cc) * 64 + dl]; }
#pragma unroll
            for (int i = 0; i < 16; ++i) { const LAS f32x4* xp = (const LAS f32x4*)(xcs + i * 512 + n * 64 + c0);
#pragma unroll
                for (int c4 = 0; c4 < 4; ++c4) { const f32x4 v = xp[c4];
                    ra[i] += v.x * wq[4 * c4] + v.y * wq[4 * c4 + 1] + v.z * wq[4 * c4 + 2] + v.w * wq[4 * c4 + 3];
                    ri[i] += v.x * wv[4 * c4] + v.y * wv[4 * c4 + 1] + v.z * wv[4 * c4 + 2] + v.w * wv[4 * c4 + 3]; } }
        }
#pragma unroll
        for (int i = 0; i < 16; ++i) {
            const float r = 1.f / (1.f + expf(-ra[i])), ig = 1.f / (1.f + expf(-ri[i]));
            const float la = -8.f * r * sp; const float a = expf(la);
            const float bin = sqrtf(-expm1f(2.f * la)) * (ig * xc[i]);
            h = a * h + bin; cum *= a;
            const size_t o = (size_t)(t0 + sub * 16 + i) * 512 + d;
            WSF(WS_LA)[o] = a; WSF(WS_LB)[o] = bin;
        }
        __syncthreads();
    }
    WSF(WS_AGG)[(size_t)chunk * 1024 + d] = cum; WSF(WS_AGG)[(size_t)chunk * 1024 + 512 + d] = h;
}
__device__ __forceinline__ void lru_final_and_combine(Frame& F, const Args& args, int chunk) {
    const int d = F.tid; const int t0 = chunk * LCH;
    float hc = 0.f;
    int j = 0;
    for (; j + 8 <= chunk; j += 8) { float a[8], b[8];
#pragma unroll
        for (int u = 0; u < 8; ++u) { a[u] = WSF(WS_AGG)[(size_t)(j + u) * 1024 + d]; b[u] = WSF(WS_AGG)[(size_t)(j + u) * 1024 + 512 + d]; }
#pragma unroll
        for (int u = 0; u < 8; ++u) hc = a[u] * hc + b[u]; }
    for (; j < chunk; ++j) hc = WSF(WS_AGG)[(size_t)j * 1024 + d] * hc + WSF(WS_AGG)[(size_t)j * 1024 + 512 + d];
#pragma unroll 1
    for (int i0 = 0; i0 < LCH; i0 += 8) { float a[8], b[8], y[8];
#pragma unroll
        for (int u = 0; u < 8; ++u) { const size_t o = (size_t)(t0 + i0 + u) * 512 + d; a[u] = WSF(WS_LA)[o]; b[u] = WSF(WS_LB)[o]; y[u] = bf2f(WSB(WS_YG)[o]); }
#pragma unroll
        for (int u = 0; u < 8; ++u) { hc = a[u] * hc + b[u]; WSB(WS_MIX)[(size_t)(t0 + i0 + u) * 1024 + d] = (bf16)f2bf(hc * gelu_tanh_f(y[u])); } }
    float s1 = args.in[I_LQ1][F.lane] * args.in[I_LK1][F.lane], s2 = args.in[I_LQ2][F.lane] * args.in[I_LK2][F.lane];
    s1 = wave_sum(s1); s2 = wave_sum(s2);
    const float lam = expf(s1) - expf(s2) + 0.2f;
    const float g0 = args.in[I_GSUB][2 * F.lane], g1v = args.in[I_GSUB][2 * F.lane + 1];
    for (int it = F.wave; it < LCH * 4; it += NWAVES) {
        const int t = t0 + (it >> 2), hh = it & 3;
        const unsigned w0 = *(const GAS unsigned*)(WSB(WS_OM) + (size_t)t * 1024 + (hh * 2) * 128 + 2 * F.lane);
        const unsigned w1 = *(const GAS unsigned*)(WSB(WS_OM) + (size_t)t * 1024 + (hh * 2 + 1) * 128 + 2 * F.lane);
        const float da = __uint_as_float(w0 << 16) - lam * __uint_as_float(w1 << 16), db = __uint_as_float(w0 & 0xffff0000u) - lam * __uint_as_float(w1 & 0xffff0000u);
        const float ss = wave_sum(da * da + db * db);
        const float r = 0.8f / sqrtf(ss * (1.f / 128.f) + EPS);
        *(GAS unsigned*)(WSB(WS_MIX) + (size_t)t * 1024 + 512 + hh * 128 + 2 * F.lane) = pk2(da * r * g0, db * r * g1v);
    }
}
__device__ __forceinline__ void build_bias_tables(Frame& F, const Args& args) {
    LAS float* tbl = (LAS float*)(F.lds + TBL_OFF);
    for (int idx = F.tid; idx < 4 * 640; idx += NWAVES * 64) { const int hh = idx / 640, rel = idx % 640 - 255;
        float v = 0.f;
        if (rel < 0) v = -INFINITY; else if (rel < 113) v = (args.in[I_RELB][t5_bucket(rel) * 4 + hh] - args.in[I_RELB][31 * 4 + hh]) * 1.4426950408889634f;
        tbl[idx] = v; }
    __syncthreads();
}

__global__ void __launch_bounds__(NWAVES * 64, 2) mega_fwd(Args args) {
    extern __shared__ __attribute__((aligned(16))) unsigned char lds[];
    Frame F;
    F.lds = (LAS unsigned char*)lds;
    F.MISC = (volatile LAS unsigned*)(F.lds + MISC_OFF);
    F.tid = threadIdx.x; F.lane = F.tid & 63; F.wave = __builtin_amdgcn_readfirstlane(F.tid >> 6);
    F.G = gridDim.x; { const int bx = blockIdx.x; F.vcu = (F.G % 8 == 0) ? (bx % 8) * (F.G / 8) + bx / 8 : bx; }
    unsigned char* ws = args.ws;
    for (int u = F.tid; u < (LDS_BYTES - LDSCTL_OFF) / 4; u += NWAVES * 64) ((LAS unsigned*)(F.lds + LDSCTL_OFF))[u] = 0u;
    __syncthreads();
    XcdBarrier bar = xcd_barrier_post((unsigned*)(ws + WS_CTL) + CW_BAR, F.MISC + 8);
#define GRID_BAR() xcd_barrier(bar)
    LAS float* U = (LAS float*)(F.lds + RING_OFF); LAS float* SH = U + D;

#ifndef SKIP_P0a
    p0a_prologue(F, args);
#endif
    GRID_BAR();
#ifndef SKIP_P0b
    { const int gi = blockIdx.x * (NWAVES * 64) + F.tid;
      if (gi < NMOD) { float s = 0.f; for (int kc = 0; kc < 16; ++kc) s += WSF(WS_MODP)[(size_t)kc * NMOD + gi]; WSF(WS_MOD)[gi] = s; }
      build_mod_tables(F, args, args.in[I_G1], 1024, 0, true, U, SH);
      norm_rows_bf16(F, args.in[I_X], WSB(WS_XN), U, SH); }
#endif
    GRID_BAR();
#ifndef SKIP_P1
    { pg8::Gemm g{WSB(WS_XN), WSB(WS_WIN), M, DIN, D}; pg8::StaticOrder S; S.init(M, DIN, F.G, (int)blockIdx.x);
      pg8::EpiBf16<0> E{WSB(WS_Q), 512, nullptr, 512, (size_t)(WS_K - WS_Q) / 2, attn_body::C2};
      pg8::gemm_phase<pg8::EpiBf16<0>, pg8::StaticOrder, PG8_ALIGN, PG8_SP2>(F.lds + RING_OFF, g, S, E); }
#endif
    GRID_BAR();
#ifndef SKIP_P2
    { for (int ch = blockIdx.x; ch < NCH; ch += F.G) lru_local(F, args, ch);
      build_bias_tables(F, args);
      const attn_body::AttnTensors AT{(const attn_body::bf16*)WSB(WS_Q), (const attn_body::bf16*)WSB(WS_K), (const attn_body::bf16*)WSB(WS_V), (attn_body::bf16*)WSB(WS_OM)};
      const attn_body::StaticOrder S((int)F.G, (int)blockIdx.x);
      attn_body::attn_phase<attn_body::StaticOrder>((char*)lds + RING_OFF, AT, S, (attn_body::lds_fptr)(F.lds + TBL_OFF)); }
#endif
    GRID_BAR();
#ifndef SKIP_P2b
    for (int ch = blockIdx.x; ch < NCH; ch += F.G) lru_final_and_combine(F, args, ch);
#endif
    GRID_BAR();
#ifndef SKIP_P3
    { pg8::Gemm g{WSB(WS_MIX), WSB(WS_WOUT), M, D, D}; pg8::StaticOrder S; S.init(M, D, F.G, (int)blockIdx.x);
      pg8::EpiResGate E{args.in[I_X], args.out, D, WSF(WS_MOD) + 2048};
      pg8::gemm_phase<pg8::EpiResGate, pg8::StaticOrder, PG8_ALIGN, PG8_SP2>(F.lds + RING_OFF, g, S, E); }
#endif
    GRID_BAR();
#ifndef SKIP_P3b
    { build_mod_tables(F, args, args.in[I_G2], 4096, 3072, false, U, SH);
      norm_rows_bf16(F, args.out, WSB(WS_XN), U, SH); }
#endif
    GRID_BAR();
#ifndef SKIP_P4a
    { pg8::Gemm g{WSB(WS_XN), WSB(WS_WUP), M, DFF, D}; pg8::StaticOrder S; S.init(M, DFF, F.G, (int)blockIdx.x);
      pg8::EpiBf16<0> E{WSB(WS_AB), DFF, nullptr, 0, 0, 1.f};
      pg8::gemm_phase<pg8::EpiBf16<0>, pg8::StaticOrder, PG8_ALIGN, PG8_SP2>(F.lds + RING_OFF, g, S, E); }
#endif
    GRID_BAR();
#ifndef SKIP_P4c
    { pg8::Gemm g{WSB(WS_XN), WSB(WS_WUP) + (size_t)DFF * D, M, DFF, D}; pg8::StaticOrder S; S.init(M, DFF, F.G, (int)blockIdx.x);
      pg8::EpiConvGate E{WSB(WS_AB), WSB(WS_HM), DFF, args.in[I_CFW], args.in[I_CFB]};
      pg8::gemm_phase<pg8::EpiConvGate, pg8::StaticOrder, PG8_ALIGN, PG8_SP2>(F.lds + RING_OFF, g, S, E); }
#endif
    GRID_BAR();
#ifndef SKIP_P5
    { pg8::Gemm g{WSB(WS_HM), WSB(WS_WDN), M, D, DFF}; pg8::StaticOrder S; S.init(M, D, F.G, (int)blockIdx.x);
      pg8::EpiResGate E{args.out, args.out, D, WSF(WS_MOD) + 5120};
      pg8::gemm_phase<pg8::EpiResGate, pg8::StaticOrder, PG8_ALIGN, PG8_SP2>(F.lds + RING_OFF, g, S, E); }
#endif
    GRID_BAR();
#ifndef SKIP_P5b
    final_norm_rows(F, args.out, args.in[I_GFIN]);
#endif
}

extern "C" void kernel_launch(void* const* d_in, const int* in_sizes, int n_in, void* d_out, int out_size, void* d_ws, size_t ws_size, hipStream_t stream) {
    static int grid = 0;
    if (grid == 0) {
        if (n_in != 26 || out_size != M * D || ws_size < WS_END) { fprintf(stderr, "kernel_launch: unexpected shapes (n_in %d, out %d, ws %zu)\n", n_in, out_size, ws_size); grid = -1; return; }
        int dev = 0, cus = 0, per_cu = 0;
        if (hipGetDevice(&dev) != hipSuccess || hipDeviceGetAttribute(&cus, hipDeviceAttributeMultiprocessorCount, dev) != hipSuccess) { grid = -1; return; }
        if (hipFuncSetAttribute((const void*)mega_fwd, hipFuncAttributeMaxDynamicSharedMemorySize, LDS_BYTES) != hipSuccess) { fprintf(stderr, "kernel_launch: hipFuncSetAttribute failed\n"); grid = -1; return; }
        if (hipOccupancyMaxActiveBlocksPerMultiprocessor(&per_cu, (const void*)mega_fwd, NWAVES * 64, LDS_BYTES) != hipSuccess || per_cu < 1) { fprintf(stderr, "kernel_launch: occupancy query reports %d blocks per CU\n", per_cu); per_cu = 1; }
        (void)hipGetLastError();
        grid = cus < 256 ? cus : 256;
    }
    if (grid < 0) return;
    if (hipMemsetAsync((char*)d_ws + WS_CTL, 0, CTL_ZERO_BYTES, stream) != hipSuccess) return;
    Args a{};
    for (int i = 0; i < 26; ++i) a.in[i] = (const float*)d_in[i];
    a.out = (float*)d_out; a.ws = (unsigned char*)d_ws;
    hipLaunchKernelGGL(mega_fwd, dim3(grid), dim3(NWAVES * 64), LDS_BYTES, stream, a);
}
```

```cpp
#include <hip/hip_runtime.h>
#include <hip/hip_bf16.h>
#include <cstdio>
#include <cstdint>
#include <cmath>

namespace pg8 {
#define PG8_LAS __attribute__((address_space(3)))
typedef unsigned short bf16_t;
typedef short bf16x8 __attribute__((ext_vector_type(8)));
typedef float f32x4 __attribute__((ext_vector_type(4)));
typedef unsigned u32x4 __attribute__((ext_vector_type(4)));
constexpr int BM = 256, BK = 64, HALF = 128, HTB = HALF * BK * 2  , STAGE_BYTES = 8 * HTB, NXCD = 8, WGM = 8;

__host__ __device__ __forceinline__ int lds_byte(int r, int c) { const int st = (r >> 4) * 2 + (c >> 5), rr = r & 15, cc = c & 31, ob = rr * 64 + cc * 2; return st * 1024 + (ob ^ (((ob >> 9) & 1) << 5)); }
__host__ __device__ __forceinline__ void stage_rc(int b, int& R, int& C) { const int st = b / 1024, sb = b % 1024, swz = sb ^ (((sb >> 9) & 1) << 5); R = (st >> 1) * 16 + swz / 64; C = (st & 1) * 32 + (swz % 64) / 2; }
__host__ __device__ __forceinline__ int perm32(int rho) { const int n = rho >> 4, i = rho & 15; return 8 * (i >> 2) + 4 * n + (i & 3); }

struct Unit { int pm, pn; };
struct Gemm { const bf16_t* A; const bf16_t* Bt; int M, N, K; };

struct StaticOrder {
    int nM, nN, nwg, G, c;
    __host__ __device__ void init(int M, int N, int G_, int c_) { nM = M / BM; nN = N / BM; nwg = nM * nN; G = G_; c = c_; }
    __host__ __device__ bool next(int i, Unit& u) const {
        const long L = (long)i * G + c; if (L >= nwg) return false;
        int wgid = (int)L; { const int q = nwg / NXCD, r = nwg % NXCD, xcd = wgid % NXCD, off = wgid / NXCD; wgid = (xcd < r ? xcd * (q + 1) : r * (q + 1) + (xcd - r) * q) + off; }
        const int nig = WGM * nN, gid = wgid / nig, fm = gid * WGM, gsz = (nM - fm) < WGM ? (nM - fm) : WGM;
        u.pm = fm + ((wgid % nig) % gsz); u.pn = (wgid % nig) / gsz; return true;
    }
    __device__ __forceinline__ void a_ready(const Unit&) const {}
    __device__ __forceinline__ void done(const Unit&) const {}
};

__device__ __forceinline__ unsigned cvt_pk_bf16(float lo, float hi) { unsigned r; asm volatile("v_cvt_pk_bf16_f32 %0, %1, %2" : "=v"(r) : "v"(lo), "v"(hi)); return r; }
typedef float f32x2 __attribute__((ext_vector_type(2)));
__device__ __forceinline__ f32x2 gelu_pk(f32x2 v) {
    const f32x2 av = __builtin_elementwise_abs(v), d = av * 0.2316418882f + 1.0f;
    f32x2 t; t.x = __builtin_amdgcn_rcpf(d.x); t.y = __builtin_amdgcn_rcpf(d.y);
    f32x2 q = t * 0.5307027145f + (-0.7265760135f); q = q * t + 0.7107068705f; q = q * t + (-0.142248368f); q = q * t + 0.127414796f; q = q * t;
    const f32x2 s = (v * v) * (-0.72134752044f);
    f32x2 e; e.x = __builtin_amdgcn_exp2f(s.x); e.y = __builtin_amdgcn_exp2f(s.y);
    const f32x2 m = v * (q * e), r = v - m;
    f32x2 o; o.x = v.x < 0.f ? m.x : r.x; o.y = v.y < 0.f ? m.y : r.y; return o;
}

template <int ACT  > struct EpiBf16 {
    static constexpr bool PERM = true, AFTER_DRAIN = false; static_assert(ACT == 0 || ACT == 1, "EpiBf16: ACT is 0 (none) or 1 (gelu_pk)");
    bf16_t* O; int ldc; const float* bias; int split_cols; size_t split_stride; float scale0;
    __device__ __forceinline__ void operator()(const f32x4 (&acc)[2][2][4][2], const Unit& u, int wr, int wc, int fr, int fq) const {
        const int row0 = u.pm * BM + wr * 64 + fr; int colt = u.pn * BM; bf16_t* base = O;
        float sc = 1.f; if (split_cols) { const int t = colt / split_cols; base += (size_t)t * split_stride; colt -= t * split_cols; if (t == 0) sc = scale0; }
        const int col0 = colt + wc * 32 + 8 * fq, bcol0 = u.pn * BM + wc * 32 + 8 * fq;
        f32x4 bv[2][2];
#pragma unroll
        for (int bj = 0; bj < 2; ++bj)
#pragma unroll
            for (int n = 0; n < 2; ++n) bv[bj][n] = bias ? *(const f32x4*)(bias + bcol0 + bj * HALF + 4 * n) : (f32x4){0.f, 0.f, 0.f, 0.f};
#pragma unroll
        for (int ai = 0; ai < 2; ++ai)
#pragma unroll
            for (int m = 0; m < 4; ++m) { bf16_t* rowp = base + (size_t)(row0 + ai * HALF + m * 16) * ldc + col0;
#pragma unroll
                for (int bj = 0; bj < 2; ++bj) { f32x4 v0 = acc[ai][bj][m][0] + bv[bj][0], v1 = acc[ai][bj][m][1] + bv[bj][1];
                    if (ACT == 1) { f32x2 a = gelu_pk((f32x2){v0[0], v0[1]}), b = gelu_pk((f32x2){v0[2], v0[3]}), c = gelu_pk((f32x2){v1[0], v1[1]}), d = gelu_pk((f32x2){v1[2], v1[3]});
                        v0 = (f32x4){a.x, a.y, b.x, b.y}; v1 = (f32x4){c.x, c.y, d.x, d.y}; }
                    v0 = v0 * sc; v1 = v1 * sc; u32x4 w; w.x = cvt_pk_bf16(v0[0], v0[1]); w.y = cvt_pk_bf16(v0[2], v0[3]); w.z = cvt_pk_bf16(v1[0], v1[1]); w.w = cvt_pk_bf16(v1[2], v1[3]);
                    *(u32x4*)(rowp + bj * HALF) = w; } }
    }
};

struct EpiResGate {
    static constexpr bool PERM = false, AFTER_DRAIN = false;
    const float* base; float* out; int ldc; const float* gate;
    __device__ __forceinline__ void operator()(const f32x4 (&acc)[2][2][4][2], const Unit& u, int wr, int wc, int fr, int fq) const {
        const int col0 = u.pn * BM + wc * 32 + 4 * fq;
        f32x4 gv[2][2];
#pragma unroll
        for (int bj = 0; bj < 2; ++bj)
#pragma unroll
            for (int n = 0; n < 2; ++n) gv[bj][n] = *(const f32x4*)(gate + col0 + bj * HALF + n * 16);
#pragma unroll
        for (int ai = 0; ai < 2; ++ai)
#pragma unroll
            for (int m = 0; m < 4; ++m) { const size_t off = (size_t)(u.pm * BM + ai * HALF + wr * 64 + m * 16 + fr) * ldc + col0;
#pragma unroll
                for (int bj = 0; bj < 2; ++bj)
#pragma unroll
                    for (int n = 0; n < 2; ++n) { const f32x4 bs = *(const f32x4*)(base + off + bj * HALF + n * 16); *(f32x4*)(out + off + bj * HALF + n * 16) = bs + gv[bj][n] * acc[ai][bj][m][n]; } }
    }
};
__device__ __forceinline__ float bf_lo(unsigned w) { return __uint_as_float(w << 16); }
__device__ __forceinline__ float bf_hi(unsigned w) { return __uint_as_float(w & 0xffff0000u); }
__device__ __forceinline__ float gelu_t(float y) { const float t = y * (1.0f + 0.044715f * y * y); const float e = __builtin_amdgcn_exp2f(-2.302208198f * t); return y * __builtin_amdgcn_rcpf(1.0f + e); }
struct EpiConvGate {
    static constexpr bool PERM = true, AFTER_DRAIN = false;
    const bf16_t* Ab; bf16_t* O; int ldc; const float* cw; const float* cb;
    __device__ __forceinline__ void operator()(const f32x4 (&acc)[2][2][4][2], const Unit& u, int wr, int wc, int fr, int fq) const {
        const int row0 = u.pm * BM + wr * 64 + fr, col0 = u.pn * BM + wc * 32 + 8 * fq;
#pragma unroll
        for (int bj = 0; bj < 2; ++bj) { const int c = col0 + bj * HALF;
            f32x4 w0[2], w1[2], w2[2], bb[2];
#pragma unroll
            for (int n = 0; n < 2; ++n) { w0[n] = *(const f32x4*)(cw + c + 4 * n); w1[n] = *(const f32x4*)(cw + ldc + c + 4 * n); w2[n] = *(const f32x4*)(cw + 2 * ldc + c + 4 * n); bb[n] = *(const f32x4*)(cb + c + 4 * n); }
#pragma unroll
            for (int ai = 0; ai < 2; ++ai)
#pragma unroll
                for (int m = 0; m < 4; ++m) { const int r = row0 + ai * HALF + m * 16; const bf16_t* ap = Ab + (size_t)r * ldc + c;
                    const u32x4 a2 = *(const u32x4*)ap; u32x4 a1 = (u32x4){0u, 0u, 0u, 0u}, a0 = (u32x4){0u, 0u, 0u, 0u};
                    if (r >= 1) a1 = *(const u32x4*)(ap - ldc);
                    if (r >= 2) a0 = *(const u32x4*)(ap - 2 * ldc);
                    u32x4 w;
#pragma unroll
                    for (int n = 0; n < 2; ++n) { const f32x4 g = acc[ai][bj][m][n]; float y[4];
                        y[0] = bb[n][0] + w0[n][0] * bf_lo(a0[2 * n]) + w1[n][0] * bf_lo(a1[2 * n]) + w2[n][0] * bf_lo(a2[2 * n]);
                        y[1] = bb[n][1] + w0[n][1] * bf_hi(a0[2 * n]) + w1[n][1] * bf_hi(a1[2 * n]) + w2[n][1] * bf_hi(a2[2 * n]);
                        y[2] = bb[n][2] + w0[n][2] * bf_lo(a0[2 * n + 1]) + w1[n][2] * bf_lo(a1[2 * n + 1]) + w2[n][2] * bf_lo(a2[2 * n + 1]);
                        y[3] = bb[n][3] + w0[n][3] * bf_hi(a0[2 * n + 1]) + w1[n][3] * bf_hi(a1[2 * n + 1]) + w2[n][3] * bf_hi(a2[2 * n + 1]);
                        w[2 * n] = cvt_pk_bf16(gelu_t(y[0]) * g[0], gelu_t(y[1]) * g[1]); w[2 * n + 1] = cvt_pk_bf16(gelu_t(y[2]) * g[2], gelu_t(y[3]) * g[3]); }
                    *(u32x4*)(O + (size_t)r * ldc + c) = w; } }
    }
};

template <class Epi, class Sched, bool ALIGN_EPI = false, bool SP2 = false>
__device__ __forceinline__ void gemm_phase(PG8_LAS unsigned char* lds, const Gemm g, const Sched& S, const Epi& E) {
    int tid_ = threadIdx.x; asm volatile("" : "+v"(tid_));
    const int tid = tid_, wid = __builtin_amdgcn_readfirstlane(tid >> 6), lane = tid & 63, wr = wid >> 2, wc = wid & 3, fr = lane & 15, fq = lane >> 4;
    const int K = g.K, nt = K / BK;
    unsigned voffA[2], voffB[2];
#pragma unroll
    for (int i = 0; i < 2; ++i) { int R, C; stage_rc(tid * 16 + i * 8192, R, C); const int Rb = Epi::PERM ? ((R & ~31) + perm32(R & 31)) : R;
        voffA[i] = (unsigned)(R * K + C) * 2u; voffB[i] = (unsigned)(Rb * K + C) * 2u; }
    const size_t kstep = (size_t)(BK * 2);
    const size_t hstep = (size_t)HALF * K * 2;
    const size_t tstep = 2 * hstep;
    const unsigned ldsw = (unsigned)wid * 1024u;
    const int aoff = lds_byte(wr * 64 + fr, fq * 8), boff = lds_byte(wc * 32 + fr, fq * 8);
#define PG8_SA(b, h) (((b) * 2 + (h)) * HTB)
#define PG8_SB(b, h) ((4 + (b) * 2 + (h)) * HTB)
#define PG8_STAGE(bufoff, gbase, voff) do { _Pragma("unroll") for (int _i = 0; _i < 2; ++_i) \
        __builtin_amdgcn_global_load_lds((const unsigned*)((const char*)(gbase) + (voff)[_i]), (PG8_LAS unsigned*)(lds + (bufoff) + ldsw + _i * 8192), 16, 0, 0); } while (0)
#define PG8_LDA(dst, b, h) do { _Pragma("unroll") for (int m = 0; m < 4; ++m) _Pragma("unroll") for (int k = 0; k < 2; ++k) dst[m][k] = *(const PG8_LAS bf16x8*)(lds + PG8_SA(b, h) + aoff + m * 2048 + k * 1024); } while (0)
#define PG8_LDB(dst, b, h) do { _Pragma("unroll") for (int n = 0; n < 2; ++n) _Pragma("unroll") for (int k = 0; k < 2; ++k) dst[n][k] = *(const PG8_LAS bf16x8*)(lds + PG8_SB(b, h) + boff + n * 2048 + k * 1024); } while (0)
#define PG8_MMA(ai, bj, At, Bt) do { __builtin_amdgcn_s_setprio(1); _Pragma("unroll") for (int m = 0; m < 4; ++m) _Pragma("unroll") for (int n = 0; n < 2; ++n) _Pragma("unroll") for (int k = 0; k < 2; ++k) \
        acc[ai][bj][m][n] = __builtin_amdgcn_mfma_f32_16x16x32_bf16(Bt[n][k], At[m][k], acc[ai][bj][m][n], 0, 0, 0); __builtin_amdgcn_s_setprio(0); } while (0)
#define PG8_WAIT_V(n) asm volatile("s_waitcnt vmcnt(" #n ")" ::: "memory")
#define PG8_WAIT_L(n) asm volatile("s_waitcnt lgkmcnt(" #n ")" ::: "memory")
#define PG8_BAR __builtin_amdgcn_s_barrier()
#define PG8_SCHED __builtin_amdgcn_sched_barrier(0)
    Unit cur, nxt; int ui = 0;
    if (!S.next(0, cur)) return;
    f32x4 acc[2][2][4][2];
#pragma unroll
    for (int a = 0; a < 2; ++a)
#pragma unroll
        for (int b = 0; b < 2; ++b)
#pragma unroll
            for (int m = 0; m < 4; ++m)
#pragma unroll
                for (int n = 0; n < 2; ++n) acc[a][b][m][n] = (f32x4){0.f, 0.f, 0.f, 0.f};
    bf16x8 At[4][2], B0[2][2], B1[2][2];
    const char* cA = (const char*)g.A + (size_t)cur.pm * tstep; const char* cB = (const char*)g.Bt + (size_t)cur.pn * tstep;
    S.a_ready(cur);
    if constexpr (SP2) {
        PG8_STAGE(PG8_SB(0, 0), cB, voffB); PG8_STAGE(PG8_SB(0, 1), cB + hstep, voffB); PG8_STAGE(PG8_SA(0, 0), cA, voffA); PG8_STAGE(PG8_SA(0, 1), cA + hstep, voffA);
        if (wr == 1) PG8_BAR;
        PG8_WAIT_V(2); PG8_BAR;
        PG8_STAGE(PG8_SB(1, 0), cB + kstep, voffB); PG8_STAGE(PG8_SA(1, 0), cA + kstep, voffA); PG8_STAGE(PG8_SB(1, 1), cB + hstep + kstep, voffB);
        PG8_WAIT_V(6); PG8_BAR;
    } else {
        PG8_STAGE(PG8_SB(0, 0), cB, voffB); PG8_STAGE(PG8_SA(0, 0), cA, voffA); PG8_STAGE(PG8_SB(0, 1), cB + hstep, voffB); PG8_STAGE(PG8_SA(0, 1), cA + hstep, voffA);
        if (wr == 1) PG8_BAR;
        PG8_WAIT_V(4); PG8_BAR;
        PG8_STAGE(PG8_SB(1, 0), cB + kstep, voffB); PG8_STAGE(PG8_SA(1, 0), cA + kstep, voffA); PG8_STAGE(PG8_SB(1, 1), cB + hstep + kstep, voffB);
        PG8_WAIT_V(6); PG8_BAR;
    }
    for (;;) {
        const bool has_next = S.next(ui + 1, nxt);
        const char* nA = has_next ? (const char*)g.A + (size_t)nxt.pm * tstep : cA; const char* nB = has_next ? (const char*)g.Bt + (size_t)nxt.pn * tstep : cB;
        for (int t = 0; t < nt; t += 2) {
            const bool last = (t == nt - 2);
            const char* a1 = cA + (size_t)(t + 1) * kstep;
            const char* a2 = last ? nA : cA + (size_t)(t + 2) * kstep; const char* b2 = last ? nB : cB + (size_t)(t + 2) * kstep;
            const char* a3 = a2 + kstep; const char* b3 = b2 + kstep;
            if (last && has_next) S.a_ready(nxt);
            if constexpr (SP2) {
            PG8_LDB(B0, 0, 0); PG8_LDB(B1, 0, 1); PG8_SCHED; PG8_LDA(At, 0, 0); PG8_STAGE(PG8_SA(1, 1), a1 + hstep, voffA);
            PG8_WAIT_V(8); PG8_WAIT_L(0); PG8_BAR; PG8_MMA(0, 0, At, B0); PG8_MMA(0, 1, At, B1); PG8_BAR; PG8_SCHED;
            PG8_LDA(At, 0, 1); PG8_STAGE(PG8_SB(0, 0), b2, voffB); PG8_STAGE(PG8_SB(0, 1), b2 + hstep, voffB); PG8_STAGE(PG8_SA(0, 0), a2, voffA);
            PG8_WAIT_V(8); PG8_WAIT_L(0); PG8_BAR; PG8_MMA(1, 0, At, B0); PG8_MMA(1, 1, At, B1); PG8_BAR; PG8_SCHED;
            PG8_LDB(B0, 1, 0); PG8_LDB(B1, 1, 1); PG8_SCHED; PG8_LDA(At, 1, 0); PG8_STAGE(PG8_SA(0, 1), a2 + hstep, voffA);
            PG8_WAIT_V(8); PG8_WAIT_L(0); PG8_BAR; PG8_MMA(0, 0, At, B0); PG8_MMA(0, 1, At, B1); PG8_BAR; PG8_SCHED;
            PG8_LDA(At, 1, 1); PG8_STAGE(PG8_SB(1, 0), b3, voffB); PG8_STAGE(PG8_SB(1, 1), b3 + hstep, voffB); PG8_STAGE(PG8_SA(1, 0), a3, voffA);
            PG8_WAIT_V(8); PG8_WAIT_L(0); PG8_BAR; PG8_MMA(1, 0, At, B0); PG8_MMA(1, 1, At, B1); PG8_BAR; PG8_SCHED;
            } else {
            PG8_LDB(B0, 0, 0); PG8_SCHED; PG8_LDA(At, 0, 0); PG8_STAGE(PG8_SA(1, 1), a1 + hstep, voffA);
            PG8_WAIT_L(8); PG8_BAR; PG8_WAIT_L(0); PG8_MMA(0, 0, At, B0); PG8_BAR; PG8_SCHED;
            PG8_LDB(B1, 0, 1); PG8_STAGE(PG8_SB(0, 0), b2, voffB);
            PG8_BAR; PG8_WAIT_L(0); PG8_MMA(0, 1, At, B1); PG8_BAR;
            PG8_LDA(At, 0, 1); PG8_STAGE(PG8_SA(0, 0), a2, voffA);
            PG8_BAR; PG8_WAIT_L(0); PG8_MMA(1, 0, At, B0); PG8_BAR; PG8_SCHED;
            PG8_STAGE(PG8_SB(0, 1), b2 + hstep, voffB);
            PG8_WAIT_V(6); PG8_BAR; PG8_MMA(1, 1, At, B1); PG8_BAR;
            PG8_LDB(B0, 1, 0); PG8_SCHED; PG8_LDA(At, 1, 0); PG8_STAGE(PG8_SA(0, 1), a2 + hstep, voffA);
            PG8_WAIT_L(8); PG8_BAR; PG8_WAIT_L(0); PG8_MMA(0, 0, At, B0); PG8_BAR; PG8_SCHED;
            PG8_LDB(B1, 1, 1); PG8_STAGE(PG8_SB(1, 0), b3, voffB);
            PG8_BAR; PG8_WAIT_L(0); PG8_MMA(0, 1, At, B1); PG8_BAR;
            PG8_LDA(At, 1, 1); PG8_STAGE(PG8_SA(1, 0), a3, voffA);
            PG8_BAR; PG8_WAIT_L(0); PG8_MMA(1, 0, At, B0); PG8_BAR; PG8_SCHED;
            PG8_STAGE(PG8_SB(1, 1), b3 + hstep, voffB);
            PG8_WAIT_V(6); PG8_BAR; PG8_MMA(1, 1, At, B1); PG8_BAR;
            }
        }
        if constexpr (ALIGN_EPI) { if (wr == 0) PG8_BAR; }
        if constexpr (!Epi::AFTER_DRAIN) { E(acc, cur, wr, wc, fr, fq); S.done(cur); }
        if (!has_next) break;
#pragma unroll
        for (int a = 0; a < 2; ++a)
#pragma unroll
            for (int b = 0; b < 2; ++b)
#pragma unroll
                for (int m = 0; m < 4; ++m)
#pragma unroll
                    for (int n = 0; n < 2; ++n) acc[a][b][m][n] = (f32x4){0.f, 0.f, 0.f, 0.f};
        cur = nxt; cA = nA; cB = nB; ++ui;
        if constexpr (ALIGN_EPI) { if (wr == 1) PG8_BAR; }
    }
    PG8_WAIT_V(0);
    if constexpr (!ALIGN_EPI) { if (wr == 0) PG8_BAR; }
    PG8_BAR;
    if constexpr (Epi::AFTER_DRAIN) { E.fused(acc, cur, wr, wc, fr, fq, lds, wid, lane); S.done(cur); }
#undef PG8_SA
#undef PG8_SB
#undef PG8_STAGE
#undef PG8_LDA
#undef PG8_LDB
#undef PG8_MMA
#undef PG8_WAIT_V
#undef PG8_WAIT_L
#undef PG8_BAR
#undef PG8_SCHED
}
}

#ifndef PG8_SP2
#define PG8_SP2 true
#endif
#ifndef PG8_ALIGN
#define PG8_ALIGN true
#endif
namespace attn2 {
using bf16=__hip_bfloat16;
using bf16x8=__attribute__((ext_vector_type(8)))short;
using s16x4=__attribute__((ext_vector_type(4)))short;
using f32x16=__attribute__((ext_vector_type(16)))float;
using u32x4=__attribute__((ext_vector_type(4)))unsigned;
constexpr int SEQ=16384,D=64,PQ=512,PO=1024;
constexpr int NW=8,QBLK=32,QB=128,KVBLK=64,NQB=SEQ/QB;
__device__ __forceinline__ int crow(int r,int hi){return (r&3)+8*(r>>2)+4*hi;}
#define SBAR() __builtin_amdgcn_sched_barrier(0)
typedef __attribute__((address_space(3))) const float* lds_fptr;
__device__ __forceinline__ void bmask(f32x16&p0,f32x16&p1,int jb,int qrel,int hi,lds_fptr tb){
  const lds_fptr p=tb+(qrel-64*jb-4*hi+255);
  #pragma unroll
  for(int r=0;r<16;++r){const int o=(r&3)+8*(r>>2); p0[r]+=p[-o]; p1[r]+=p[-o-32];}
}
constexpr int NSLOT=3, SLOTB=16384;
constexpr int LDS_K=0, LDS_V=NSLOT*SLOTB, LDS_TBL=2*NSLOT*SLOTB, LDS_WS=LDS_TBL+4*640*4, LDS_BYTES=LDS_WS+NW*64*4;
constexpr float C2=0.125f*1.4426950408889634f;
__device__ __forceinline__ void glds16s(const void*gbase,unsigned voff,unsigned lds_dst){unsigned keep;
  asm volatile("s_nop 4\n\ts_mov_b32 %0, m0\n\ts_mov_b32 m0, %2\n\ts_nop 0\n\tglobal_load_lds_dwordx4 %1, %3\n\ts_mov_b32 m0, %0":"=&s"(keep):"v"(voff),"s"(lds_dst),"s"(gbase):"memory");}
__device__ __forceinline__ float max3f(float a,float b,float c){float r;asm("v_max3_f32 %0, %1, %2, %3":"=v"(r):"v"(a),"v"(b),"v"(c));return r;}
__device__ __forceinline__ float max2f(float a,float b){float r;asm("v_max_f32_e32 %0, %1, %2":"=v"(r):"v"(a),"v"(b));return r;}
__device__ __forceinline__ float fadd_s(float a,float b){float r;asm("v_add_f32_e32 %0, %1, %2":"=v"(r):"v"(a),"v"(b));return r;}
__device__ __forceinline__ float fsub_s(float a,float b){float r;asm("v_sub_f32_e32 %0, %1, %2":"=v"(r):"v"(a),"v"(b));return r;}
typedef float f32x2_t __attribute__((ext_vector_type(2))); typedef __bf16 bf16x2_t __attribute__((ext_vector_type(2)));
__device__ __forceinline__ unsigned cvtpk_s(float lo,float hi){f32x2_t v={lo,hi};bf16x2_t b=__builtin_convertvector(v,bf16x2_t);return __builtin_bit_cast(unsigned,b);}
#define WAIT_BAR(N) asm volatile("s_waitcnt vmcnt(" #N ") lgkmcnt(0)\n\ts_barrier":::"memory")
__device__ __forceinline__ void qkt(f32x16&p0,f32x16&p1,const char*Kslot,const bf16x8*qr,int r32,int hi){
  const char*kb=Kslot+hi*1024+r32*16;
  #pragma unroll
  for(int d0=0;d0<4;++d0){
    const bf16x8 b0=*reinterpret_cast<const bf16x8*>(kb+d0*2048);
    const bf16x8 b1=*reinterpret_cast<const bf16x8*>(kb+d0*2048+512);
    if(d0==0){p0=__builtin_amdgcn_mfma_f32_32x32x16_bf16(b0,qr[0],f32x16{},0,0,0);p1=__builtin_amdgcn_mfma_f32_32x32x16_bf16(b1,qr[0],f32x16{},0,0,0);}
    else{p0=__builtin_amdgcn_mfma_f32_32x32x16_bf16(b0,qr[d0],p0,0,0,0);p1=__builtin_amdgcn_mfma_f32_32x32x16_bf16(b1,qr[d0],p1,0,0,0);}}
}
typedef __attribute__((address_space(3))) const char* lds_cptr;
typedef short v4i16_t __attribute__((ext_vector_type(4)));
__device__ __forceinline__ void kload8(bf16x8*kf,lds_cptr kp){
  kf[0]=*(const __attribute__((address_space(3))) bf16x8*)(kp);      kf[1]=*(const __attribute__((address_space(3))) bf16x8*)(kp+512);
  kf[2]=*(const __attribute__((address_space(3))) bf16x8*)(kp+2048); kf[3]=*(const __attribute__((address_space(3))) bf16x8*)(kp+2560);
  kf[4]=*(const __attribute__((address_space(3))) bf16x8*)(kp+4096); kf[5]=*(const __attribute__((address_space(3))) bf16x8*)(kp+4608);
  kf[6]=*(const __attribute__((address_space(3))) bf16x8*)(kp+6144); kf[7]=*(const __attribute__((address_space(3))) bf16x8*)(kp+6656);
}
__device__ __forceinline__ void kload2(bf16x8*kf,lds_cptr kp,int j){ kf[2*j]=*(const __attribute__((address_space(3))) bf16x8*)(kp+j*2048); kf[2*j+1]=*(const __attribute__((address_space(3))) bf16x8*)(kp+j*2048+512); }
__device__ __forceinline__ s16x4 vtr(lds_cptr p){ return __builtin_bit_cast(s16x4,__builtin_amdgcn_ds_read_tr16_b64_v4i16((__attribute__((address_space(3))) v4i16_t*)p)); }
__device__ __forceinline__ float rowmax(const f32x16&p0,const f32x16&p1){
  float a=max3f(p0[0],p0[1],p1[0]),b=max3f(p0[2],p0[3],p1[1]);a=max3f(a,p1[2],p1[3]);
  #pragma unroll
  for(int r=4;r<16;r+=4){a=max3f(a,p0[r],p0[r+1]);b=max3f(b,p0[r+2],p0[r+3]);a=max3f(a,p1[r],p1[r+1]);b=max3f(b,p1[r+2],p1[r+3]);}
  const float m=max2f(a,b);
  auto rr=__builtin_amdgcn_permlane32_swap(__float_as_uint(m),__float_as_uint(m),false,false);
  return max2f(__uint_as_float(rr[0]),__uint_as_float(rr[1]));
}
__device__ __forceinline__ void pv(f32x16*o,int vb,bf16x8 pa0,bf16x8 pa1,bf16x8 pa2,bf16x8 pa3){
  #pragma unroll
  for(int d0=0;d0<4;++d0){s16x4 lo[4],hi[4];
    #pragma unroll
    for(int ks=0;ks<4;++ks){
      asm volatile("ds_read_b64_tr_b16 %0,%1 offset:%c2":"=&v"(lo[ks]):"v"(vb),"i"(d0*4096+ks*1024):"memory");
      asm volatile("ds_read_b64_tr_b16 %0,%1 offset:%c2":"=&v"(hi[ks]):"v"(vb),"i"(d0*4096+ks*1024+512):"memory");}
    asm volatile("s_waitcnt lgkmcnt(0)":::"memory");SBAR();
    #define PK(k) (bf16x8){lo[k][0],lo[k][1],lo[k][2],lo[k][3],hi[k][0],hi[k][1],hi[k][2],hi[k][3]}
    o[d0]=__builtin_amdgcn_mfma_f32_32x32x16_bf16(pa0,PK(0),o[d0],0,0,0);
    o[d0]=__builtin_amdgcn_mfma_f32_32x32x16_bf16(pa1,PK(1),o[d0],0,0,0);
    o[d0]=__builtin_amdgcn_mfma_f32_32x32x16_bf16(pa2,PK(2),o[d0],0,0,0);
    o[d0]=__builtin_amdgcn_mfma_f32_32x32x16_bf16(pa3,PK(3),o[d0],0,0,0);
    #undef PK
  }
}
__device__ __forceinline__ int lane_opaque(){ int t_=threadIdx.x; asm volatile("":"+v"(t_)); return t_&63; }
struct AttnTensors { const bf16* Q; const bf16* K; const bf16* V; bf16* MIX; const float* gsub; float lam; };
template<int THRL> __device__ __forceinline__ void attn_unit(int h,int qb,const AttnTensors&T,char*shm,lds_fptr tb){
  int tid_=threadIdx.x; asm volatile("":"+v"(tid_));
  const int tid=tid_,lane=tid&63,r32=lane&31,hi=lane>>5; const int wid=__builtin_amdgcn_readfirstlane(tid>>6);
  const int mp=wid>>2, jg=wid&3;
  const int q0=qb*QB;
  const bf16*Qw=T.Q+(long)(q0+jg*QBLK)*PQ+(h*2+mp)*D;
  const bf16*Kh=T.K+h*128,*Vh=T.V+h*128;
  const unsigned lds0=(unsigned)(uintptr_t)shm;
  const __attribute__((address_space(3))) float*const wsf0=(const __attribute__((address_space(3))) float*)((lds_cptr)shm+LDS_WS)+wid*64;
  #define WSF ((__attribute__((address_space(3))) float*)wsf0)
  const unsigned kvo=(unsigned)(lane*PQ+wid*8)*2u;
  const unsigned vvo=(unsigned)((16*(wid&3)+(lane>>2))*PQ+(wid>>2)*32+(lane&3)*8)*2u;
  const unsigned kdst=lds0+LDS_K+wid*1024, vdst=lds0+LDS_V+wid*1024;
  #define DMA_K(t,slot) do{ glds16s(Kh+(long)(t)*KVBLK*PQ,kvo,(unsigned)__builtin_amdgcn_readfirstlane(kdst+(slot))); glds16s(Kh+64+(long)(t)*KVBLK*PQ,kvo,(unsigned)__builtin_amdgcn_readfirstlane(kdst+(slot)+8192)); }while(0)
  #define DMA_V(t,slot) do{ glds16s(Vh+(long)(t)*KVBLK*PQ,vvo,(unsigned)__builtin_amdgcn_readfirstlane(vdst+(slot))); glds16s(Vh+64+(long)(t)*KVBLK*PQ,vvo,(unsigned)__builtin_amdgcn_readfirstlane(vdst+(slot)+8192)); }while(0)
  const char*Kbase=shm+LDS_K+mp*8192; bf16x8 kf[8];
  const lds_cptr shm3=(lds_cptr)shm; const lds_cptr kp0=shm3+LDS_K+mp*8192+hi*1024+r32*16; const lds_cptr vp0=shm3+LDS_V+((lane>>4)&1)*32+(lane&3)*8+(4*hi+((lane&15)>>2))*64;
  const int NT=(q0+QB)/KVBLK;
  DMA_K(0,0);DMA_V(0,0);DMA_K(1,SLOTB);
  bf16x8 qr[4];
  #pragma unroll
  for(int d0=0;d0<4;++d0)qr[d0]=*reinterpret_cast<const bf16x8*>(&Qw[(long)r32*PQ+d0*16+hi*8]);
  float mhat=0.f,l_reg=0.f;f32x16 o[4];o[0]=f32x16{};o[1]=f32x16{};o[2]=f32x16{};o[3]=f32x16{};
  #define CMASK(P0,P1,t) do{int jb_=(t)-(NT-2); if(jb_>=-2){const int l2_=lane_opaque(); bmask(P0,P1,jb_,jg*QBLK+(l2_&31),l2_>>5,tb);}}while(0)
  bool resc=false;
  #define START(P0,P1) do{ const float rm=rowmax(P0,P1); resc=false; mhat=fadd_s(mhat,rm); \
    _Pragma("unroll") for(int r=0;r<16;++r)P0[r]=__builtin_amdgcn_exp2f(P0[r]-mhat); }while(0)
  #define RESC() do{ if(resc){ asm volatile("s_waitcnt lgkmcnt(0)":::"memory"); \
      const int hi2_=lane_opaque()>>5; _Pragma("unroll") for(int d_=0;d_<4;++d_) _Pragma("unroll") for(int r=0;r<16;++r)o[d_][r]*=WSF[crow(r,hi2_)]; } }while(0)
  f32x16 pA0,pA1,pB0,pB1;
  int sl_prev=0,sl_cur=0,sl_next=SLOTB;
  #define ROT() do{sl_prev=sl_cur;sl_cur=sl_next;sl_next=(sl_next==(NSLOT-1)*SLOTB)?0:sl_next+SLOTB;}while(0)
  #define ENDW(tt) do{ if((tt)+3<NT){WAIT_BAR(4);} else if((tt)+2<NT){WAIT_BAR(2);} else {WAIT_BAR(0);} }while(0)
  if(NT>2){ DMA_K(2,2*SLOTB); WAIT_BAR(6); } else { WAIT_BAR(4); }
  qkt(pA0,pA1,Kbase,qr,r32,hi);asm volatile("s_nop 15\n\ts_nop 7":"+v"(pA0),"+v"(pA1));CMASK(pA0,pA1,0);
  START(pA0,pA1);
  _Pragma("unroll") for(int r=0;r<16;++r)pA1[r]=__builtin_amdgcn_exp2f(pA1[r]-mhat);
  WAIT_BAR(0);
  if(NT>3){DMA_K(3,0);} DMA_V(1,SLOTB);
  ROT();
  kload8(kf,kp0+sl_cur);
  ENDW(0);
  s16x4 vlo[8],vhi[8],wlo[8],whi[8]; u32x4 pw0,pw1,pw2,pw3;
  #define PKW(P,B) cvtpk_s(P[B],P[B+1])
  #define PAF(k) __builtin_bit_cast(bf16x8,pw##k)
  #define VFR(i) (bf16x8){vlo[i][0],vlo[i][1],vlo[i][2],vlo[i][3],vhi[i][0],vhi[i][1],vhi[i][2],vhi[i][3]}
  #define WFR(i) (bf16x8){wlo[i][0],wlo[i][1],wlo[i][2],wlo[i][3],whi[i][0],whi[i][1],whi[i][2],whi[i][3]}
  #define PIN(x) asm volatile("":"+v"(x))
  #define MX3(a,b,c) __builtin_fmaxf(__builtin_fmaxf((a),(b)),(c))
  #define GAPA(MF,A0,A1,A2,A3,W0,W1,PW) do{ MF; sacc+=A0; sacc+=A1; sacc+=A2; sacc+=A3; PIN(sacc); W0; W1; PIN(PW); SBAR(); }while(0)
  #define EX(v) __builtin_amdgcn_exp2f((v)-mhat)
  #define GAPB(MF,X,B) do{ MF; X[B]=EX(X[B]); X[B+1]=EX(X[B+1]); PIN(X); SBAR(); }while(0)
  #define VRD(i) do{ vlo[i]=vtr(vp_+(((i)>>2)*4096+((i)&3)*1024)); vhi[i]=vtr(vp_+(((i)>>2)*4096+((i)&3)*1024+512)); }while(0)
  #define WRD(i) do{ wlo[i]=vtr(vp_+(8192+((i)>>2)*4096+((i)&3)*1024)); whi[i]=vtr(vp_+(8192+((i)>>2)*4096+((i)&3)*1024+512)); SBAR(); }while(0)
  #define KRD(G,j) do{ if(G){ kload2(kf,kp0+sl_next,j); SBAR(); } }while(0)
  #define MFMA_(a,b,c) __builtin_amdgcn_mfma_f32_32x32x16_bf16(a,b,c,0,0,0)
  #define STEP(C0,C1,P0,P1,t,GK,GV,GL) do{ SBAR(); \
    const lds_cptr vp_=vp0+sl_prev; \
    VRD(0); SBAR(); float sacc=(P0[0]+P0[1]); \
    GAPA(C0=MFMA_(kf[0],qr[0],f32x16{}), P0[2],P0[3],P0[4],P0[5],     pw0[0]=PKW(P0,0), pw0[1]=PKW(P0,2), pw0); \
    VRD(4); SBAR(); GAPA(C1=MFMA_(kf[1],qr[0],f32x16{}), P0[6],P0[7],P0[8],P0[9],     pw0[2]=PKW(P0,4), pw0[3]=PKW(P0,6), pw0); \
    VRD(1); SBAR(); GAPA(C0=MFMA_(kf[2],qr[1],C0),   P0[10],P0[11],P0[12],P0[13], pw1[0]=PKW(P0,8), pw1[1]=PKW(P0,10), pw1); \
    VRD(5); SBAR(); GAPA(C1=MFMA_(kf[3],qr[1],C1),   P0[14],P0[15],P1[0],P1[1],   pw1[2]=PKW(P0,12),pw1[3]=PKW(P0,14), pw1); \
    VRD(2); SBAR(); GAPA(C0=MFMA_(kf[4],qr[2],C0),   P1[2],P1[3],P1[4],P1[5],     pw2[0]=PKW(P1,0), pw2[1]=PKW(P1,2), pw2); \
    VRD(6); SBAR(); GAPA(C1=MFMA_(kf[5],qr[2],C1),   P1[6],P1[7],P1[8],P1[9],     pw2[2]=PKW(P1,4), pw2[3]=PKW(P1,6), pw2); \
    VRD(3); SBAR(); GAPA(C0=MFMA_(kf[6],qr[3],C0),   P1[10],P1[11],P1[12],P1[13], pw3[0]=PKW(P1,8), pw3[1]=PKW(P1,10), pw3); \
    VRD(7); SBAR(); GAPA(C1=MFMA_(kf[7],qr[3],C1),   P1[14],P1[15],0.f,0.f,       pw3[2]=PKW(P1,12),pw3[3]=PKW(P1,14), pw3); \
    l_reg+=sacc; \
    if(GK){DMA_K((t)+3,sl_cur);} if(GV){DMA_V((t)+1,sl_next);} \
    CMASK(C0,C1,t); \
    { float a=MX3(C0[0],C0[1],C1[0]),b=MX3(C0[2],C0[3],C1[1]); a=MX3(a,C1[2],C1[3]); \
      _Pragma("unroll") for(int r=4;r<16;r+=4){a=MX3(a,C0[r],C0[r+1]);b=MX3(b,C0[r+2],C0[r+3]);a=MX3(a,C1[r],C1[r+1]);b=MX3(b,C1[r+2],C1[r+3]);} \
      float rm=__builtin_fmaxf(a,b); { auto rr=__builtin_amdgcn_permlane32_swap(__float_as_uint(rm),__float_as_uint(rm),false,false); rm=__builtin_fmaxf(__uint_as_float(rr[0]),__uint_as_float(rr[1])); } \
      resc=false; rm-=mhat; \
      if(__builtin_expect(__any(rm>(float)THRL),0)){ const float dl=__builtin_fmaxf(rm,0.f); mhat+=dl; \
        const float f=__builtin_amdgcn_exp2f(-dl); l_reg*=f; { const int l2_=lane_opaque(); if(l2_<32)WSF[l2_]=f; } resc=true; } } \
    SBAR(); \
    WRD(0); GAPB(o[0]=MFMA_(PAF(0),VFR(0),o[0]), C0,0); \
    WRD(4); GAPB(o[1]=MFMA_(PAF(0),VFR(4),o[1]), C0,2); \
    WRD(1); GAPB(o[0]=MFMA_(PAF(1),VFR(1),o[0]), C0,4); \
    WRD(5); GAPB(o[1]=MFMA_(PAF(1),VFR(5),o[1]), C0,6); \
    WRD(2); GAPB(o[0]=MFMA_(PAF(2),VFR(2),o[0]), C0,8); \
    WRD(6); GAPB(o[1]=MFMA_(PAF(2),VFR(6),o[1]), C0,10); \
    WRD(3); GAPB(o[0]=MFMA_(PAF(3),VFR(3),o[0]), C0,12); \
    WRD(7); GAPB(o[1]=MFMA_(PAF(3),VFR(7),o[1]), C0,14); \
    GAPB(o[2]=MFMA_(PAF(0),WFR(0),o[2]), C1,0); \
    GAPB(o[3]=MFMA_(PAF(0),WFR(4),o[3]), C1,2); \
    KRD(GL,0); GAPB(o[2]=MFMA_(PAF(1),WFR(1),o[2]), C1,4); \
    KRD(GL,1); GAPB(o[3]=MFMA_(PAF(1),WFR(5),o[3]), C1,6); \
    KRD(GL,2); GAPB(o[2]=MFMA_(PAF(2),WFR(2),o[2]), C1,8); \
    KRD(GL,3); GAPB(o[3]=MFMA_(PAF(2),WFR(6),o[3]), C1,10); \
    GAPB(o[2]=MFMA_(PAF(3),WFR(3),o[2]), C1,12); \
    GAPB(o[3]=MFMA_(PAF(3),WFR(7),o[3]), C1,14); \
    }while(0)
  int t=1;
  #undef CMASK
  #define CMASK(P0,P1,t) do{}while(0)
  for(;t+5<NT;t+=2){
    STEP(pB0,pB1,pA0,pA1,t,true,true,true);     WAIT_BAR(4); RESC(); ROT();
    STEP(pA0,pA1,pB0,pB1,t+1,true,true,true);   WAIT_BAR(4); RESC(); ROT();
  }
  #undef CMASK
  #define CMASK(P0,P1,t) do{int jb_=(t)-(NT-2); if(jb_>=-2){const int l2_=lane_opaque(); bmask(P0,P1,jb_,jg*QBLK+(l2_&31),l2_>>5,tb);}}while(0)
  for(;t+1<NT;t+=2){
    STEP(pB0,pB1,pA0,pA1,t,(t+3<NT),(t+1<NT),(t+1<NT));       ENDW(t);   RESC(); ROT();
    STEP(pA0,pA1,pB0,pB1,t+1,(t+4<NT),(t+2<NT),(t+2<NT));     ENDW(t+1); RESC(); ROT();
  }
  STEP(pB0,pB1,pA0,pA1,NT-1,false,false,false); RESC();
  { float sacc=pB0[0]+pB0[1]; _Pragma("unroll") for(int r=2;r<16;++r)sacc+=pB0[r]; _Pragma("unroll") for(int r=0;r<16;++r)sacc+=pB1[r]; l_reg+=sacc;
    pw0=(u32x4){PKW(pB0,0),PKW(pB0,2),PKW(pB0,4),PKW(pB0,6)};pw1=(u32x4){PKW(pB0,8),PKW(pB0,10),PKW(pB0,12),PKW(pB0,14)};pw2=(u32x4){PKW(pB1,0),PKW(pB1,2),PKW(pB1,4),PKW(pB1,6)};pw3=(u32x4){PKW(pB1,8),PKW(pB1,10),PKW(pB1,12),PKW(pB1,14)};
    SBAR(); pv(o,(int)(unsigned)(uintptr_t)(vp0+sl_cur),PAF(0),PAF(1),PAF(2),PAF(3)); }
  #undef PKW
  #undef PAF
  #undef VFR
  #undef WFR
  #undef PIN
  #undef MX3
  #undef GAPA
  #undef GAPB
  #undef EX
  #undef VRD
  #undef WRD
  #undef KRD
  #undef STEP
  #undef ENDW
  #undef MFMA_
  {auto rr=__builtin_amdgcn_permlane32_swap(__float_as_uint(l_reg),__float_as_uint(l_reg),false,false);l_reg=__uint_as_float(rr[0])+__uint_as_float(rr[1]);}
  const int le=lane_opaque(), r32e=le&31, hie=le>>5;
  if(hie==0)WSF[32+r32e]=l_reg;
  asm volatile("s_waitcnt vmcnt(0) lgkmcnt(0)\n\ts_barrier":::"memory");
  float rli[16];
  #pragma unroll
  for(int r=0;r<16;++r)rli[r]=__builtin_amdgcn_rcpf(WSF[32+crow(r,hie)]);
  { __attribute__((address_space(3))) unsigned short*stg=(__attribute__((address_space(3))) unsigned short*)(shm3)+wid*4096;
    #pragma unroll
    for(int r=0;r<16;++r){const int orow=crow(r,hie);
      #pragma unroll
      for(int d0=0;d0<4;++d0)stg[orow*128+d0*32+r32e]=(unsigned short)cvtpk_s(o[d0][r]*rli[r],0.f);} }
  asm volatile("s_waitcnt lgkmcnt(0)\n\ts_barrier":::"memory");
  { const float g0=T.gsub[2*le], g1=T.gsub[2*le+1]; const float lam=T.lam;
    #pragma unroll 4
    for(int i=0;i<16;++i){ const int R=wid*16+i, jj=R>>5, q=R&31;
      const unsigned w0=*(const __attribute__((address_space(3))) unsigned*)(shm3+(jj*4096+q*128+2*le)*2), w1=*(const __attribute__((address_space(3))) unsigned*)(shm3+((4+jj)*4096+q*128+2*le)*2);
      const float da=__uint_as_float(w0<<16)-lam*__uint_as_float(w1<<16), db=__uint_as_float(w0&0xffff0000u)-lam*__uint_as_float(w1&0xffff0000u);
      float ss=da*da+db*db;
      #pragma unroll
      for(int of=1;of<64;of<<=1)ss+=__shfl_xor(ss,of);
      const float rr_=0.8f/sqrtf(ss*(1.f/128.f)+1e-6f);
      *(unsigned*)(T.MIX+(long)(q0+R)*PO+512+h*128+2*le)=cvtpk_s(da*rr_*g0,db*rr_*g1); } }
  asm volatile("s_waitcnt lgkmcnt(0)\n\ts_barrier":::"memory");
  #undef DMA_K
  #undef DMA_V
  #undef CMASK
  #undef START
  #undef RESC
  #undef ROT
  #undef WSF
}
constexpr int ATTN_LDS_BYTES=LDS_BYTES;
struct AttnUnit { int h; int qb; };
struct StaticOrder {
  int vcu, G;
  __device__ __forceinline__ explicit StaticOrder(int grid,int block):vcu((grid%8==0)?(block%8)*(grid/8)+block/8:block),G(grid){}
  __device__ __forceinline__ bool next(int i,AttnUnit&u)const{ const int vc=vcu+(i>>1)*G; if(vc>=256)return false; const int s=vc&63; u.h=vc>>6; u.qb=(i&1)?s:127-s; return true; }
};
template<class Sched,int THRL=8> __device__ __forceinline__ void attn_phase(char*lds,const AttnTensors&T,const Sched&S){
  AttnUnit u;
  for(int i=0;S.next(i,u);++i){ attn_unit<THRL>(u.h,u.qb,T,lds,(lds_fptr)(lds+LDS_TBL)+u.h*640); }
}
#undef SBAR
#undef WAIT_BAR
}

#define GAS __attribute__((address_space(1)))
#define LAS __attribute__((address_space(3)))
typedef unsigned short bf16;
typedef unsigned v4u __attribute__((ext_vector_type(4)));
typedef float f32x4 __attribute__((ext_vector_type(4)));
typedef short bf16x8 __attribute__((ext_vector_type(8)));
typedef GAS unsigned gu32;
typedef GAS unsigned long long gu64;
#define RLX_AGENT __ATOMIC_RELAXED, __HIP_MEMORY_SCOPE_AGENT
#define LDS_WAIT() asm volatile("s_waitcnt lgkmcnt(0)" ::: "memory")
#define VM_WAIT() asm volatile("s_waitcnt vmcnt(0)" ::: "memory")
__device__ __forceinline__ unsigned long long rt() { return __builtin_amdgcn_s_memrealtime(); }
__device__ __forceinline__ unsigned f2bf(float f) { unsigned u = __builtin_bit_cast(unsigned, f); return (u + 0x7fffu + ((u >> 16) & 1u)) >> 16; }
__device__ __forceinline__ unsigned pk2(float lo, float hi) { return f2bf(lo) | (f2bf(hi) << 16); }

#define XB_TMO      128
#define XB_XCNT(j)  (256  + 64 * (j))
#define XB_XSUB(j)  (1280 + 64 * (j))
#define XB_XGEN(j)  (2304 + 64 * (j))
#define XB_TOP      3328
#define XB_TOPGEN   3392
#define XCD_BAR_WORDS 3456
#define XB_SPIN_CAP (1u << 18)

__device__ __forceinline__ unsigned xb_ld(unsigned* p)              { return __hip_atomic_load(p, __ATOMIC_RELAXED, __HIP_MEMORY_SCOPE_AGENT); }
__device__ __forceinline__ unsigned xb_add(unsigned* p, unsigned v) { return __hip_atomic_fetch_add(p, v, __ATOMIC_RELAXED, __HIP_MEMORY_SCOPE_AGENT); }
__device__ __forceinline__ unsigned xb_xcc_id() { return (unsigned)__builtin_amdgcn_s_getreg((3 << 11) | 20) & 0xFu; }
#define XB_SPIN(cond, bar) do { unsigned _sp = 0; while (cond) { __builtin_amdgcn_s_sleep(1); \
    if ((++_sp & 255u) == 0u) { if (xb_ld(&(bar)[XB_TMO])) break; if (_sp > XB_SPIN_CAP) { atomicAdd(&(bar)[XB_TMO], 1u); break; } } } } while (0)

struct XcdBarrier {
    unsigned* bar; unsigned x;
    volatile LAS unsigned* st;
};

__device__ __forceinline__ XcdBarrier xcd_barrier_post(unsigned* bar, volatile LAS unsigned* st) {
    XcdBarrier b; b.bar = bar; b.x = xb_xcc_id(); b.st = st;
    if (threadIdx.x == 0) (void)xb_add(&bar[XB_XCNT(b.x)], 1u);
    return b;
}
__device__ __forceinline__ void xcd_barrier_complete(unsigned* bar, unsigned x, unsigned& nloc, unsigned& nx) {
    const unsigned G = gridDim.x * gridDim.y * gridDim.z;
    unsigned sum, cnt, mine, sp = 0u;
    for (;;) {
        sum = 0u; cnt = 0u; mine = 0u;
#pragma unroll
        for (unsigned j = 0; j < 16; ++j) { const unsigned c = xb_ld(&bar[XB_XCNT(j)]); sum += c; cnt += (c > 0u) ? 1u : 0u; mine = (j == x) ? c : mine; }
        if (sum == G) break;
        __builtin_amdgcn_s_sleep(1);
        if ((++sp & 255u) == 0u) { if (xb_ld(&bar[XB_TMO])) break; if (sp > XB_SPIN_CAP) { atomicAdd(&bar[XB_TMO], 1u); break; } }
    }
    nloc = mine > 0u ? mine : 1u; nx = cnt > 0u ? cnt : 1u;
}

__device__ __forceinline__ void xcd_barrier(const XcdBarrier& b) {
    asm volatile("s_waitcnt vmcnt(0)" ::: "memory");
    __syncthreads();
    if (threadIdx.x == 0) {
        unsigned* bar = b.bar;
        __builtin_amdgcn_s_waitcnt(0);
        unsigned nloc = b.st[0], nx = b.st[1];
        if (nloc == 0u) { xcd_barrier_complete(bar, b.x, nloc, nx); b.st[0] = nloc; b.st[1] = nx; }
        const unsigned old = xb_add(&bar[XB_XSUB(b.x)], 1u);
        const unsigned gen = old / nloc;
        if (old + 1u == (gen + 1u) * nloc) {
            __builtin_amdgcn_fence(__ATOMIC_RELEASE, "agent");
            asm volatile("s_waitcnt vmcnt(0)" ::: "memory");
            const unsigned og = xb_add(&bar[XB_TOP], 1u);
            const unsigned tg = og / nx;
            if (og + 1u == (tg + 1u) * nx) xb_add(&bar[XB_TOPGEN], 1u);
            else XB_SPIN(xb_ld(&bar[XB_TOPGEN]) == tg, bar);
            __builtin_amdgcn_fence(__ATOMIC_ACQUIRE, "agent");
            xb_add(&bar[XB_XGEN(b.x)], 1u);
            asm volatile("s_waitcnt vmcnt(0)" ::: "memory");
        } else {
            XB_SPIN(xb_ld(&bar[XB_XGEN(b.x)]) == gen, bar);
            __builtin_amdgcn_fence(__ATOMIC_ACQUIRE, "agent");
            asm volatile("s_waitcnt vmcnt(0)" ::: "memory");
        }
    }
    __syncthreads();
}
constexpr int NWAVES = 8;
constexpr int M = 16384, D = 1024, DIN = 2560, DFF = 3072, NMOD = 6144;
constexpr float EPS = 1e-6f;
constexpr int LCH = 64, NCH = M / LCH;

constexpr size_t MiB = 1u << 20;
constexpr size_t WS_CTL = 0, CTL_ZERO_BYTES = 64 * 1024;
constexpr size_t WS_MOD = 1 * MiB;
constexpr size_t WS_MODP = WS_MOD + 64 * 1024;
constexpr size_t WS_AGG = WS_MOD + 512 * 1024;
constexpr size_t WS_WIN = 2 * MiB, WS_WOUT = 7 * MiB, WS_WUP = 9 * MiB, WS_WDN = 21 * MiB;
constexpr size_t WS_XN = 27 * MiB;
constexpr size_t WS_Q = 59 * MiB, WS_K = 75 * MiB, WS_V = 91 * MiB, WS_XR = 107 * MiB, WS_YG = 123 * MiB;
constexpr size_t WS_LA = 171 * MiB, WS_LB = 203 * MiB;
constexpr size_t WS_MIX = 139 * MiB;
constexpr size_t WS_AB = 59 * MiB, WS_HM = 155 * MiB;
constexpr size_t WS_END = 251 * MiB;
static_assert(WS_LB + 32 * MiB <= WS_END && WS_HM + 96 * MiB <= WS_END && WS_AB + 96 * MiB <= WS_HM, "d_ws map");
constexpr int CW_BAR = 1024;
constexpr int RING_OFF = 0, RING_BYTES = 131072;
constexpr int TBL_OFF = 98304;
constexpr int LDSCTL_OFF = RING_BYTES, MISC_OFF = LDSCTL_OFF + 320;
constexpr int LDS_BYTES = 147456;
static_assert(MISC_OFF + 128 <= LDS_BYTES && attn2::LDS_TBL == TBL_OFF && attn2::LDS_BYTES <= RING_BYTES, "LDS map");

struct Args { const float* in[26]; float* out; unsigned char* ws; };
struct Frame {
    LAS unsigned char* lds;
    volatile LAS unsigned* MISC;
    int tid, lane, wave;
    int vcu, G;
};
enum { I_X = 0, I_C, I_WADA, I_BADA, I_G1, I_WIN, I_CLW, I_CLB, I_WA, I_BA, I_WX, I_BX, I_LLAM, I_LQ1, I_LK1, I_LQ2, I_LK2, I_GSUB, I_WOUT, I_G2, I_WUP, I_CFW, I_CFB, I_WDN, I_RELB, I_GFIN };
#define WSF(off) ((float*)(args.ws + (off)))
#define WSB(off) ((bf16*)(args.ws + (off)))

__device__ __forceinline__ float wave_sum(float v) {
#pragma unroll
    for (int o = 1; o < 64; o <<= 1) v += __shfl_xor(v, o);
    return v;
}
__device__ __forceinline__ float bf2f(bf16 v) { return __uint_as_float((unsigned)v << 16); }
__device__ __forceinline__ float gelu_tanh_f(float y) { const float t = y * (1.0f + 0.044715f * y * y); const float e = __builtin_amdgcn_exp2f(-2.302208198f * t); return y * __builtin_amdgcn_rcpf(1.0f + e); }
__device__ __forceinline__ int t5_bucket(int n) {
    if (n < 16) return n;
    const int v = 16 + (int)(logf((float)n / 16.f) / logf(8.f) * 16.f);
    return v < 31 ? v : 31;
}

__device__ __forceinline__ void p0_transpose_item(const float* W, int K, int N, bf16* WT, LAS float* scr, int item, int lane) {
    const int nblk = N / 32, kb = item / nblk, nb = item % nblk, k0 = 64 * kb, n0 = 32 * nb;
#pragma unroll 8
    for (int i = 0; i < 32; ++i) { const int kk = 2 * i + (lane >> 5); scr[kk * 33 + (lane & 31)] = W[(size_t)(k0 + kk) * N + n0 + (lane & 31)]; }
    LDS_WAIT(); asm volatile("" ::: "memory");
    const int c = lane & 7;
#pragma unroll
    for (int j = 0; j < 4; ++j) { const int n = (lane >> 3) + 8 * j; const LAS float* s = scr + (8 * c) * 33 + n;
        v4u o; o.x = pk2(s[0 * 33], s[1 * 33]); o.y = pk2(s[2 * 33], s[3 * 33]); o.z = pk2(s[4 * 33], s[5 * 33]); o.w = pk2(s[6 * 33], s[7 * 33]);
        *(GAS v4u*)(WT + (size_t)(n0 + n) * K + k0 + 8 * c) = o; }
    LDS_WAIT(); asm volatile("" ::: "memory");
}
__device__ __forceinline__ void p0a_prologue(Frame& F, const Args& args) {
    LAS float* scr = (LAS float*)(F.lds + RING_OFF + F.wave * 16384);
    const int gw = F.vcu * NWAVES + F.wave, NGW = F.G * NWAVES;
    for (int it = gw; it < 24 * 16; it += NGW) {
        const int cc = it % 24, kc = it / 24; const int col = cc * 256 + F.lane * 4;
        f32x4 acc = (f32x4){0.f, 0.f, 0.f, 0.f};
        if (kc == 0) acc = *(const f32x4*)(args.in[I_BADA] + col);
#pragma unroll 8
        for (int k = 0; k < 64; ++k) { const int kk = kc * 64 + k; const float cv = args.in[I_C][kk]; const float sv = cv / (1.f + expf(-cv));
            const f32x4 w = *(const f32x4*)(args.in[I_WADA] + (size_t)kk * NMOD + col); acc += w * sv; }
        *(f32x4*)(WSF(WS_MODP) + (size_t)kc * NMOD + col) = acc;
    }
    constexpr int I_IN = (D / 64) * (DIN / 32), I_OUT = (D / 64) * (D / 32), I_UP = (D / 64) * (2 * DFF / 32), I_DN = (DFF / 64) * (D / 32);
    constexpr int NITEMS = I_IN + I_OUT + I_UP + I_DN;
    for (int it = gw; it < NITEMS; it += NGW) {
        int r = it;
        if (r < I_IN) { p0_transpose_item(args.in[I_WIN], D, DIN, WSB(WS_WIN), scr, r, F.lane); continue; } r -= I_IN;
        if (r < I_OUT) { p0_transpose_item(args.in[I_WOUT], D, D, WSB(WS_WOUT), scr, r, F.lane); continue; } r -= I_OUT;
        if (r < I_UP) { p0_transpose_item(args.in[I_WUP], D, 2 * DFF, WSB(WS_WUP), scr, r, F.lane); continue; } r -= I_UP;
        p0_transpose_item(args.in[I_WDN], DFF, D, WSB(WS_WDN), scr, r, F.lane);
    }
}
__device__ __forceinline__ void norm_rows_bf16(Frame& F, const float* X, bf16* XN, const LAS float* U, const LAS float* SH) {
    const int gw = F.vcu * NWAVES + F.wave, NGW = F.G * NWAVES;
    f32x4 u[4], s[4];
#pragma unroll
    for (int j = 0; j < 4; ++j) { u[j] = *(const LAS f32x4*)(U + 256 * j + 4 * F.lane); s[j] = *(const LAS f32x4*)(SH + 256 * j + 4 * F.lane); }
    for (int m = gw; m < M; m += NGW) {
        const GAS f32x4* xr = (const GAS f32x4*)(X + (size_t)m * D) + F.lane;
        f32x4 v[4]; float ss = 0.f;
#pragma unroll
        for (int j = 0; j < 4; ++j) { v[j] = xr[64 * j]; ss += (v[j].x * v[j].x + v[j].y * v[j].y) + (v[j].z * v[j].z + v[j].w * v[j].w); }
        const float rstd = 1.f / sqrtf(wave_sum(ss) * (1.f / D) + EPS);
        GAS unsigned long long* o8 = (GAS unsigned long long*)(XN + (size_t)m * D) + F.lane;
#pragma unroll
        for (int j = 0; j < 4; ++j) { const f32x4 o = v[j] * rstd * u[j] + s[j];
            o8[64 * j] = (unsigned long long)pk2(o.x, o.y) | ((unsigned long long)pk2(o.z, o.w) << 32); }
    }
}
__device__ __forceinline__ void build_mod_tables(Frame& F, const Args& args, const float* g, int scale_off, int shift_off, bool from_partials, LAS float* U, LAS float* SH) {
    for (int cidx = F.tid; cidx < D; cidx += NWAVES * 64) {
        float sc = 0.f, sh = 0.f;
        if (from_partials) { for (int kc = 0; kc < 16; ++kc) { sc += WSF(WS_MODP)[(size_t)kc * NMOD + scale_off + cidx]; sh += WSF(WS_MODP)[(size_t)kc * NMOD + shift_off + cidx]; } }
        else { sc = WSF(WS_MOD)[scale_off + cidx]; sh = WSF(WS_MOD)[shift_off + cidx]; }
        U[cidx] = g[cidx] * (1.f + sc); SH[cidx] = sh;
    }
    __syncthreads();
}
__device__ __forceinline__ void final_norm_rows(Frame& F, float* X, const float* g) {
    const int gw = F.vcu * NWAVES + F.wave, NGW = F.G * NWAVES;
    f32x4 u[4];
#pragma unroll
    for (int j = 0; j < 4; ++j) u[j] = *(const f32x4*)(g + 256 * j + 4 * F.lane);
    for (int m = gw; m < M; m += NGW) {
        GAS f32x4* xr = (GAS f32x4*)(X + (size_t)m * D) + F.lane;
        f32x4 v[4]; float ss = 0.f;
#pragma unroll
        for (int j = 0; j < 4; ++j) { v[j] = xr[64 * j]; ss += (v[j].x * v[j].x + v[j].y * v[j].y) + (v[j].z * v[j].z + v[j].w * v[j].w); }
        const float rstd = 1.f / sqrtf(wave_sum(ss) * (1.f / D) + EPS);
#pragma unroll
        for (int j = 0; j < 4; ++j) xr[64 * j] = v[j] * rstd * u[j];
    }
}
__device__ __forceinline__ void lru_local(Frame& F, const Args& args, int chunk) {
    const int d = F.tid, n = d >> 6, dl = d & 63;
    LAS float* xcs = (LAS float*)(F.lds + RING_OFF);
    const float cw0 = args.in[I_CLW][d], cw1 = args.in[I_CLW][512 + d], cw2 = args.in[I_CLW][1024 + d], cw3 = args.in[I_CLW][1536 + d], cbb = args.in[I_CLB][d];
    const float bav = args.in[I_BA][d], bxv = args.in[I_BX][d];
    const float sp = log1pf(expf(-args.in[I_LLAM][d]));
    const int t0 = chunk * LCH;
    const bf16* XR = WSB(WS_XR);
    float x3 = 0.f, x2 = 0.f, x1 = 0.f;
    if (t0 >= 3) { x3 = bf2f(XR[(size_t)(t0 - 3) * 512 + d]); x2 = bf2f(XR[(size_t)(t0 - 2) * 512 + d]); x1 = bf2f(XR[(size_t)(t0 - 1) * 512 + d]); }
    float h = 0.f, cum = 1.f;
#pragma unroll 1
    for (int sub = 0; sub < LCH / 16; ++sub) {
        float xc[16], ra[16], ri[16];
#pragma unroll
        for (int i = 0; i < 16; ++i) { const float x0 = bf2f(XR[(size_t)(t0 + sub * 16 + i) * 512 + d]); xc[i] = cbb + cw0 * x3 + cw1 * x2 + cw2 * x1 + cw3 * x0; x3 = x2; x2 = x1; x1 = x0; xcs[i * 512 + d] = xc[i]; ra[i] = bav; ri[i] = bxv; }
        __syncthreads();
#pragma unroll 1
        for (int c0 = 0; c0 < 64; c0 += 16) {
            float wq[16], wv[16];
#pragma unroll
            for (int cc = 0; cc < 16; ++cc) { wq[cc] = args.in[I_WA][n * 4096 + (c0 + cc) * 64 + dl]; wv[cc] = args.in[I_WX][n * 4096 + (c0 + cc) * 64 + dl]; }
#pragma unroll
            for (int i = 0; i < 16; ++i) { const LAS f32x4* xp = (const LAS f32x4*)(xcs + i * 512 + n * 64 + c0);
#pragma unroll
                for (int c4 = 0; c4 < 4; ++c4) { const f32x4 v = xp[c4];
                    ra[i] += v.x * wq[4 * c4] + v.y * wq[4 * c4 + 1] + v.z * wq[4 * c4 + 2] + v.w * wq[4 * c4 + 3];
                    ri[i] += v.x * wv[4 * c4] + v.y * wv[4 * c4 + 1] + v.z * wv[4 * c4 + 2] + v.w * wv[4 * c4 + 3]; } }
        }
#pragma unroll
        for (int i = 0; i < 16; ++i) {
            const float r = 1.f / (1.f + expf(-ra[i])), ig = 1.f / (1.f + expf(-ri[i]));
            const float la = -8.f * r * sp; const float a = expf(la);
            const float bin = sqrtf(-expm1f(2.f * la)) * (ig * xc[i]);
            h = a * h + bin; cum *= a;
            const size_t o = (size_t)(t0 + sub * 16 + i) * 512 + d;
            WSF(WS_LA)[o] = a; WSF(WS_LB)[o] = bin;
        }
        __syncthreads();
    }
    WSF(WS_AGG)[(size_t)chunk * 1024 + d] = cum; WSF(WS_AGG)[(size_t)chunk * 1024 + 512 + d] = h;
}
__device__ __forceinline__ void lru_final_and_combine(Frame& F, const Args& args, int chunk) {
    const int d = F.tid; const int t0 = chunk * LCH;
    float hc = 0.f;
    int j = 0;
    for (; j + 8 <= chunk; j += 8) { float a[8], b[8];
#pragma unroll
        for (int u = 0; u < 8; ++u) { a[u] = WSF(WS_AGG)[(size_t)(j + u) * 1024 + d]; b[u] = WSF(WS_AGG)[(size_t)(j + u) * 1024 + 512 + d]; }
#pragma unroll
        for (int u = 0; u < 8; ++u) hc = a[u] * hc + b[u]; }
    for (; j < chunk; ++j) hc = WSF(WS_AGG)[(size_t)j * 1024 + d] * hc + WSF(WS_AGG)[(size_t)j * 1024 + 512 + d];
#pragma unroll 1
    for (int i0 = 0; i0 < LCH; i0 += 8) { float a[8], b[8], y[8];
#pragma unroll
        for (int u = 0; u < 8; ++u) { const size_t o = (size_t)(t0 + i0 + u) * 512 + d; a[u] = WSF(WS_LA)[o]; b[u] = WSF(WS_LB)[o]; y[u] = bf2f(WSB(WS_YG)[o]); }
#pragma unroll
        for (int u = 0; u < 8; ++u) { hc = a[u] * hc + b[u]; WSB(WS_MIX)[(size_t)(t0 + i0 + u) * 1024 + d] = (bf16)f2bf(hc * gelu_tanh_f(y[u])); } }
}
__device__ __forceinline__ void build_bias_tables(Frame& F, const Args& args) {
    LAS float* tbl = (LAS float*)(F.lds + TBL_OFF);
    for (int idx = F.tid; idx < 4 * 640; idx += NWAVES * 64) { const int hh = idx / 640, rel = idx % 640 - 255;
        float v = 0.f;
        if (rel < 0) v = -INFINITY; else if (rel < 113) v = (args.in[I_RELB][t5_bucket(rel) * 4 + hh] - args.in[I_RELB][31 * 4 + hh]) * 1.4426950408889634f;
        tbl[idx] = v; }
    __syncthreads();
}

__global__ void __launch_bounds__(NWAVES * 64, 2) mega_fwd(Args args) {
    extern __shared__ __attribute__((aligned(16))) unsigned char lds[];
    Frame F;
    F.lds = (LAS unsigned char*)lds;
    F.MISC = (volatile LAS unsigned*)(F.lds + MISC_OFF);
    F.tid = threadIdx.x; F.lane = F.tid & 63; F.wave = __builtin_amdgcn_readfirstlane(F.tid >> 6);
    F.G = gridDim.x; { const int bx = blockIdx.x; F.vcu = (F.G % 8 == 0) ? (bx % 8) * (F.G / 8) + bx / 8 : bx; }
    unsigned char* ws = args.ws;
    for (int u = F.tid; u < (LDS_BYTES - LDSCTL_OFF) / 4; u += NWAVES * 64) ((LAS unsigned*)(F.lds + LDSCTL_OFF))[u] = 0u;
    __syncthreads();
    XcdBarrier bar = xcd_barrier_post((unsigned*)(ws + WS_CTL) + CW_BAR, F.MISC + 8);
#define GRID_BAR() xcd_barrier(bar)
    LAS float* U = (LAS float*)(F.lds + RING_OFF); LAS float* SH = U + D;

#ifndef SKIP_P0a
    p0a_prologue(F, args);
#endif
    GRID_BAR();
#ifndef SKIP_P0b
    { const int gi = blockIdx.x * (NWAVES * 64) + F.tid;
      if (gi < NMOD) { float s = 0.f; for (int kc = 0; kc < 16; ++kc) s += WSF(WS_MODP)[(size_t)kc * NMOD + gi]; WSF(WS_MOD)[gi] = s; }
      build_mod_tables(F, args, args.in[I_G1], 1024, 0, true, U, SH);
      norm_rows_bf16(F, args.in[I_X], WSB(WS_XN), U, SH); }
#endif
    GRID_BAR();
#ifndef SKIP_P1
    { pg8::Gemm g{WSB(WS_XN), WSB(WS_WIN), M, DIN, D}; pg8::StaticOrder S; S.init(M, DIN, F.G, (int)blockIdx.x);
      pg8::EpiBf16<0> E{WSB(WS_Q), 512, nullptr, 512, (size_t)(WS_K - WS_Q) / 2, attn2::C2};
      pg8::gemm_phase<pg8::EpiBf16<0>, pg8::StaticOrder, PG8_ALIGN, PG8_SP2>(F.lds + RING_OFF, g, S, E); }
#endif
    GRID_BAR();
#ifndef SKIP_P2
    { for (int ch = blockIdx.x; ch < NCH; ch += F.G) lru_local(F, args, ch);
      build_bias_tables(F, args);
      float s1 = args.in[I_LQ1][F.lane] * args.in[I_LK1][F.lane], s2 = args.in[I_LQ2][F.lane] * args.in[I_LK2][F.lane];
      s1 = wave_sum(s1); s2 = wave_sum(s2);
      const float lam = expf(s1) - expf(s2) + 0.2f;
      const attn2::AttnTensors AT{(const attn2::bf16*)WSB(WS_Q), (const attn2::bf16*)WSB(WS_K), (const attn2::bf16*)WSB(WS_V), (attn2::bf16*)WSB(WS_MIX), args.in[I_GSUB], lam};
      const attn2::StaticOrder S((int)F.G, (int)blockIdx.x);
      attn2::attn_phase<attn2::StaticOrder>((char*)lds + RING_OFF, AT, S); }
#endif
    GRID_BAR();
#ifndef SKIP_P2b
    for (int ch = blockIdx.x; ch < NCH; ch += F.G) lru_final_and_combine(F, args, ch);
#endif
    GRID_BAR();
#ifndef SKIP_P3
    { pg8::Gemm g{WSB(WS_MIX), WSB(WS_WOUT), M, D, D}; pg8::StaticOrder S; S.init(M, D, F.G, (int)blockIdx.x);
      pg8::EpiResGate E{args.in[I_X], args.out, D, WSF(WS_MOD) + 2048};
      pg8::gemm_phase<pg8::EpiResGate, pg8::StaticOrder, PG8_ALIGN, PG8_SP2>(F.lds + RING_OFF, g, S, E); }
#endif
    GRID_BAR();
#ifndef SKIP_P3b
    { build_mod_tables(F, args, args.in[I_G2], 4096, 3072, false, U, SH);
      norm_rows_bf16(F, args.out, WSB(WS_XN), U, SH); }
#endif
    GRID_BAR();
#ifndef SKIP_P4a
    { pg8::Gemm g{WSB(WS_XN), WSB(WS_WUP), M, DFF, D}; pg8::StaticOrder S; S.init(M, DFF, F.G, (int)blockIdx.x);
      pg8::EpiBf16<0> E{WSB(WS_AB), DFF, nullptr, 0, 0, 1.f};
      pg8::gemm_phase<pg8::EpiBf16<0>, pg8::StaticOrder, PG8_ALIGN, PG8_SP2>(F.lds + RING_OFF, g, S, E); }
#endif
    GRID_BAR();
#ifndef SKIP_P4c
    { pg8::Gemm g{WSB(WS_XN), WSB(WS_WUP) + (size_t)DFF * D, M, DFF, D}; pg8::StaticOrder S; S.init(M, DFF, F.G, (int)blockIdx.x);
      pg8::EpiConvGate E{WSB(WS_AB), WSB(WS_HM), DFF, args.in[I_CFW], args.in[I_CFB]};
      pg8::gemm_phase<pg8::EpiConvGate, pg8::StaticOrder, PG8_ALIGN, PG8_SP2>(F.lds + RING_OFF, g, S, E); }
#endif
    GRID_BAR();
#ifndef SKIP_P5
    { pg8::Gemm g{WSB(WS_HM), WSB(WS_WDN), M, D, DFF}; pg8::StaticOrder S; S.init(M, D, F.G, (int)blockIdx.x);
      pg8::EpiResGate E{args.out, args.out, D, WSF(WS_MOD) + 5120};
      pg8::gemm_phase<pg8::EpiResGate, pg8::StaticOrder, PG8_ALIGN, PG8_SP2>(F.lds + RING_OFF, g, S, E); }
#endif
    GRID_BAR();
#ifndef SKIP_P5b
    final_norm_rows(F, args.out, args.in[I_GFIN]);
#endif
}

extern "C" void kernel_launch(void* const* d_in, const int* in_sizes, int n_in, void* d_out, int out_size, void* d_ws, size_t ws_size, hipStream_t stream) {
    static int grid = 0;
    if (grid == 0) {
        if (n_in != 26 || out_size != M * D || ws_size < WS_END) { fprintf(stderr, "kernel_launch: unexpected shapes (n_in %d, out %d, ws %zu)\n", n_in, out_size, ws_size); grid = -1; return; }
        int dev = 0, cus = 0, per_cu = 0;
        if (hipGetDevice(&dev) != hipSuccess || hipDeviceGetAttribute(&cus, hipDeviceAttributeMultiprocessorCount, dev) != hipSuccess) { grid = -1; return; }
        if (hipFuncSetAttribute((const void*)mega_fwd, hipFuncAttributeMaxDynamicSharedMemorySize, LDS_BYTES) != hipSuccess) { fprintf(stderr, "kernel_launch: hipFuncSetAttribute failed\n"); grid = -1; return; }
        if (hipOccupancyMaxActiveBlocksPerMultiprocessor(&per_cu, (const void*)mega_fwd, NWAVES * 64, LDS_BYTES) != hipSuccess || per_cu < 1) { fprintf(stderr, "kernel_launch: occupancy query reports %d blocks per CU\n", per_cu); per_cu = 1; }
        (void)hipGetLastError();
        grid = cus < 256 ? cus : 256;
    }
    if (grid < 0) return;
    if (hipMemsetAsync((char*)d_ws + WS_CTL, 0, CTL_ZERO_BYTES, stream) != hipSuccess) return;
    Args a{};
    for (int i = 0; i < 26; ++i) a.in[i] = (const float*)d_in[i];
    a.out = (float*)d_out; a.ws = (unsigned char*)d_ws;
    hipLaunchKernelGGL(mega_fwd, dim3(grid), dim3(NWAVES * 64), LDS_BYTES, stream, a);
}
```
